# Optimizing an MI355X kernel written in HIP

```python
import math
import jax, jax.numpy as jnp
from jax import lax
import numpy as np

D_MODEL = 2048
BATCH = 16
SEQ = 2048
DEPTH = 2

N_MIXERS = 2
N_LAYERS_A = (DEPTH + 1) // 2
N_LAYERS_B = DEPTH // 2
CHUNK = 128
A_WIDTH = D_MODEL
A_GROUPS = 8
A_GROUP_DIM = A_WIDTH // A_GROUPS
B_WIDTH = D_MODEL // 2
B_CH = 16
B_GROUPS = B_WIDTH // B_CH
B_STATE = 64
DT_MIN = 1e-3
DT_MAX = 1e-1
N_EXPERTS = 16
N_EXPERT_GROUPS = 4
EXPERTS_PER_GROUP = N_EXPERTS // N_EXPERT_GROUPS
TOP_K = 2
D_FF = D_MODEL // 2
ALPHA = (2 * DEPTH) ** 0.25
BETA = (8 * DEPTH) ** -0.25
LN_EPS = 1e-5

kernel_name = "hybrid_gmlp_s5_grouped_moe_deepnorm"


def layer_norm(x, g, b):
    xf = x.astype(jnp.float32)
    mu = xf.mean(-1, keepdims=True)
    var = jnp.square(xf - mu).mean(-1, keepdims=True)
    y = (xf - mu) * lax.rsqrt(var + LN_EPS)
    return (y * g.astype(jnp.float32) + b.astype(jnp.float32)).astype(x.dtype)


def chunked_gmlp(h, w_in, b_in, ln_g, ln_b, w_s, b_s, w_out):
    bsz, s_len, _ = h.shape
    z = jax.nn.gelu(h @ w_in + b_in)
    u, v = jnp.split(z, 2, axis=-1)
    v = layer_norm(v, ln_g, ln_b)
    v = v.reshape(bsz, s_len // CHUNK, CHUNK, A_GROUPS, A_GROUP_DIM)
    causal = jnp.tril(jnp.ones((CHUNK, CHUNK), dtype=bool))
    w = jnp.where(causal, w_s, 0)
    s = jnp.einsum('gts,bcsgd->bctgd', w, v) + b_s.T[None, None, :, :, None]
    s = s.reshape(bsz, s_len, A_WIDTH)
    return (u * s) @ w_out


def _ssm_combine(lhs, rhs):
    a_l, b_l = lhs
    a_r, b_r = rhs
    return a_r * a_l, a_r * b_l + b_r


def s5_ssm(h, w_in, a_re, a_im, log_dt, b_re, b_im, c_re, c_im, d_skip, w_out):
    f32 = jnp.float32
    bsz, s_len, _ = h.shape
    uf = (h @ w_in).reshape(bsz, s_len, B_GROUPS, B_CH).astype(f32)
    a = lax.complex(a_re.astype(f32), a_im.astype(f32))
    dt = jnp.exp(log_dt.astype(f32))[:, None]
    a_bar = jnp.exp(a * dt)
    b = lax.complex(b_re.astype(f32), b_im.astype(f32))
    b_bar = ((a_bar - 1.0) / a)[..., None] * b
    bu = lax.complex(jnp.einsum('gpc,bsgc->sbgp', b_bar.real, uf),
                     jnp.einsum('gpc,bsgc->sbgp', b_bar.imag, uf))
    a_seq = jnp.broadcast_to(a_bar, (s_len, 1, B_GROUPS, B_STATE))
    _, states = lax.associative_scan(_ssm_combine, (a_seq, bu), axis=0)
    y = (jnp.einsum('gcp,sbgp->bsgc', c_re.astype(f32), states.real)
         - jnp.einsum('gcp,sbgp->bsgc', c_im.astype(f32), states.imag))
    y = y + d_skip.astype(f32) * uf
    y = jax.nn.gelu(y.reshape(bsz, s_len, B_WIDTH)).astype(h.dtype)
    val, gate = jnp.split(y @ w_out, 2, axis=-1)
    return val * jax.nn.sigmoid(gate)


def grouped_moe(h, router_w, router_b, w_in, w_out):
    f32 = jnp.float32
    bsz, s_len, d = h.shape
    t = h.reshape(-1, d)
    logits = t.astype(f32) @ router_w.astype(f32) + router_b.astype(f32)
    probs = jax.nn.softmax(logits, axis=-1)
    pg = probs.reshape(-1, N_EXPERT_GROUPS, EXPERTS_PER_GROUP)
    group_score = lax.top_k(pg, TOP_K)[0].sum(-1)
    best_group = jnp.argmax(group_score, axis=-1)
    expert_group = jnp.arange(N_EXPERTS) // EXPERTS_PER_GROUP
    in_group = expert_group[None, :] == best_group[:, None]
    masked = jnp.where(in_group, probs, -1.0)
    top_p, top_i = lax.top_k(masked, TOP_K)
    gates = top_p / top_p.sum(-1, keepdims=True)
    dense_gates = jnp.sum(jax.nn.one_hot(top_i, N_EXPERTS, dtype=f32) * gates[..., None], axis=1)
    out = jnp.zeros_like(t)
    for e in range(N_EXPERTS):
        g, u = jnp.split(t @ w_in[e], 2, axis=-1)
        y_e = (jax.nn.silu(g) * u) @ w_out[e]
        out = out + (dense_gates[:, e:e + 1] * y_e).astype(t.dtype)
    return out.reshape(bsz, s_len, d)


def setup_inputs(seed: int = 0) -> dict:
    key = jax.random.key(seed)
    ks = jax.random.split(key, 32)
    f32 = jnp.float32
    nrm = lambda k, shape, scale: jax.random.normal(k, shape, f32) * scale
    x = jax.random.normal(ks[0], (BATCH, SEQ, D_MODEL), f32)
    a_w_in = nrm(ks[1], (N_LAYERS_A, D_MODEL, 2 * A_WIDTH), D_MODEL ** -0.5)
    a_b_in = nrm(ks[2], (N_LAYERS_A, 2 * A_WIDTH), 0.02)
    a_ln_g = 1.0 + nrm(ks[3], (N_LAYERS_A, A_WIDTH), 0.02)
    a_ln_b = nrm(ks[4], (N_LAYERS_A, A_WIDTH), 0.02)
    a_w_s = nrm(ks[5], (N_LAYERS_A, A_GROUPS, CHUNK, CHUNK), 0.5 * CHUNK ** -0.5)
    a_b_s = 1.0 + nrm(ks[6], (N_LAYERS_A, A_GROUPS, CHUNK), 0.02)
    a_w_out = nrm(ks[7], (N_LAYERS_A, A_WIDTH, D_MODEL), BETA * A_WIDTH ** -0.5)
    b_w_in = nrm(ks[8], (N_LAYERS_B, D_MODEL, B_WIDTH), D_MODEL ** -0.5)
    b_a_re = -0.5 + nrm(ks[9], (N_LAYERS_B, B_GROUPS, B_STATE), 0.01)
    b_a_im = (jnp.pi * jnp.arange(B_STATE, dtype=f32))[None, None, :] + nrm(ks[10], (N_LAYERS_B, B_GROUPS, B_STATE), 0.01)
    b_log_dt = jax.random.uniform(ks[11], (N_LAYERS_B, B_GROUPS), f32,
                                  minval=math.log(DT_MIN), maxval=math.log(DT_MAX))
    b_b_re = nrm(ks[12], (N_LAYERS_B, B_GROUPS, B_STATE, B_CH), (2 * B_CH) ** -0.5)
    b_b_im = nrm(ks[13], (N_LAYERS_B, B_GROUPS, B_STATE, B_CH), (2 * B_CH) ** -0.5)
    b_c_re = nrm(ks[14], (N_LAYERS_B, B_GROUPS, B_CH, B_STATE), B_STATE ** -0.5)
    b_c_im = nrm(ks[15], (N_LAYERS_B, B_GROUPS, B_CH, B_STATE), B_STATE ** -0.5)
    b_d = nrm(ks[16], (N_LAYERS_B, B_GROUPS, B_CH), 1.0)
    w_val = nrm(ks[17], (N_LAYERS_B, B_WIDTH, D_MODEL), BETA * B_WIDTH ** -0.5)
    w_gate = nrm(ks[18], (N_LAYERS_B, B_WIDTH, D_MODEL), B_WIDTH ** -0.5)
    b_w_out = jnp.concatenate([w_val, w_gate], axis=-1)
    ln1_g = 1.0 + nrm(ks[19], (DEPTH, D_MODEL), 0.02)
    ln1_b = nrm(ks[20], (DEPTH, D_MODEL), 0.02)
    ln2_g = 1.0 + nrm(ks[21], (DEPTH, D_MODEL), 0.02)
    ln2_b = nrm(ks[22], (DEPTH, D_MODEL), 0.02)
    router_w = nrm(ks[23], (D_MODEL, N_EXPERTS), D_MODEL ** -0.5)
    router_b = nrm(ks[24], (N_EXPERTS,), 0.01)
    e_w_in = nrm(ks[25], (DEPTH, N_EXPERTS, D_MODEL, 2 * D_FF), D_MODEL ** -0.5)
    e_w_out = nrm(ks[26], (DEPTH, N_EXPERTS, D_FF, D_MODEL), BETA * D_FF ** -0.5)
    return {"x": x, "a_w_in": a_w_in, "a_b_in": a_b_in, "a_ln_g": a_ln_g, "a_ln_b": a_ln_b,
            "a_w_s": a_w_s, "a_b_s": a_b_s, "a_w_out": a_w_out,
            "b_w_in": b_w_in, "b_a_re": b_a_re, "b_a_im": b_a_im, "b_log_dt": b_log_dt,
            "b_b_re": b_b_re, "b_b_im": b_b_im, "b_c_re": b_c_re, "b_c_im": b_c_im,
            "b_d": b_d, "b_w_out": b_w_out,
            "ln1_g": ln1_g, "ln1_b": ln1_b, "router_w": router_w, "router_b": router_b,
            "e_w_in": e_w_in, "e_w_out": e_w_out, "ln2_g": ln2_g, "ln2_b": ln2_b}


def reference(x, a_w_in, a_b_in, a_ln_g, a_ln_b, a_w_s, a_b_s, a_w_out,
              b_w_in, b_a_re, b_a_im, b_log_dt, b_b_re, b_b_im, b_c_re, b_c_im,
              b_d, b_w_out, ln1_g, ln1_b, router_w, router_b, e_w_in, e_w_out,
              ln2_g, ln2_b):
    h = x
    for i in range(DEPTH):
        j = i // N_MIXERS
        if i % N_MIXERS == 0:
            mix = chunked_gmlp(h, a_w_in[j], a_b_in[j], a_ln_g[j], a_ln_b[j],
                               a_w_s[j], a_b_s[j], a_w_out[j])
        else:
            mix = s5_ssm(h, b_w_in[j], b_a_re[j], b_a_im[j], b_log_dt[j],
                         b_b_re[j], b_b_im[j], b_c_re[j], b_c_im[j], b_d[j], b_w_out[j])
        h = layer_norm(ALPHA * h + mix, ln1_g[i], ln1_b[i])
        moe = grouped_moe(h, router_w, router_b, e_w_in[i], e_w_out[i])
        h = layer_norm(ALPHA * h + moe, ln2_g[i], ln2_b[i])
    return h
```

```cpp
#include <hip/hip_runtime.h>
#include <cstdio>
#include <cstdint>

#ifndef PROBE_NOSTORE
#define PROBE_NOSTORE 0
#endif
#ifndef REPEAT_MASK
#define REPEAT_MASK 0x0
#endif
#ifndef MK_N_LAUNCHES
#define MK_N_LAUNCHES 1
#endif

#define GAS __attribute__((address_space(1)))
#define LAS __attribute__((address_space(3)))
typedef unsigned short bf16_t;
typedef short bf16x8 __attribute__((ext_vector_type(8)));
typedef float f32x4 __attribute__((ext_vector_type(4)));
typedef float f32x2 __attribute__((ext_vector_type(2)));
typedef unsigned u32x4 __attribute__((ext_vector_type(4)));
typedef unsigned u32x2 __attribute__((ext_vector_type(2)));
typedef int i32x4 __attribute__((ext_vector_type(4)));
typedef int i32x8 __attribute__((ext_vector_type(8)));

constexpr int D = 2048, NTOK = 32768, SEQ = 2048, NBATCH = 16;
constexpr int CHUNK = 128, AG = 8, AGD = 256;
constexpr int BW = 1024, BG = 64, BCH = 16, BST = 64;
constexpr int NE = 16, DFF = 1024;
constexpr float ALPHA = 1.41421356237f, LN_EPS = 1e-5f;
constexpr int NWAVES = 8, NTHR = 512;

constexpr size_t MiB = 1u << 20;
constexpr size_t WS_CTL = 0, CTL_ZERO_BYTES = 1 * MiB;
constexpr size_t WS_ROWLIST = 1 * MiB;
constexpr size_t WS_TOKI = 3 * MiB;
constexpr size_t WS_TOKG = 3 * MiB + 512 * 1024;
constexpr size_t WS_WTRIL = 3 * MiB + 768 * 1024;
constexpr size_t WS_SSMB = 4 * MiB;
constexpr size_t WS_SSME = 16 * MiB;
constexpr size_t WS_RWF = 24 * MiB;
constexpr size_t WS_WIN = 32 * MiB;
constexpr size_t WS_WOUT = 48 * MiB;
constexpr size_t WS_BWIN = 56 * MiB;
constexpr size_t WS_BWOUT = 60 * MiB;
constexpr size_t WS_EIN = 72 * MiB;
constexpr size_t WS_H8 = 136 * MiB;
constexpr size_t WS_EOUT = 200 * MiB;
constexpr size_t WS_A = 264 * MiB;
constexpr size_t WS_B = 408 * MiB;
constexpr size_t WS_C = 664 * MiB;
constexpr size_t WS_D = 792 * MiB;
constexpr size_t WS_EIN1 = 920 * MiB;
constexpr size_t WS_EOUT1 = 984 * MiB;
constexpr size_t WS_END = 1016 * MiB;
constexpr size_t WS_X8 = WS_D;
constexpr size_t WS_A2 = WS_B, WS_XEND = WS_B + 96 * MiB, WS_Y = WS_B + 160 * MiB;
constexpr int ACT_ROWS = 65536 + 16 * 256;
constexpr int CW_BAR = 4096;
constexpr int CW_CNT = 16384;

constexpr int RING_BYTES = 131072;
constexpr int LDS_ROWS = RING_BYTES;
constexpr int LDS_MOE = LDS_ROWS + 10 * 1024;
constexpr int LDS_BARW = LDS_MOE + 512;
constexpr int LDS_BYTES = 147456;

__device__ __forceinline__ unsigned cvt_pk_bf16(float lo, float hi) { unsigned r; asm("v_cvt_pk_bf16_f32 %0, %1, %2" : "=v"(r) : "v"(lo), "v"(hi)); return r; }
__device__ __forceinline__ float bf_lo(unsigned w) { return __uint_as_float(w << 16); }
__device__ __forceinline__ float bf_hi(unsigned w) { return __uint_as_float(w & 0xffff0000u); }
__device__ __forceinline__ unsigned f2bf(float f) { unsigned u = __float_as_uint(f); return (u + 0x7fffu + ((u >> 16) & 1u)) >> 16; }
__device__ __forceinline__ float wave_sum(float v) {
#pragma unroll
    for (int o = 1; o < 64; o <<= 1) v += __shfl_xor(v, o);
    return v;
}
__device__ __forceinline__ f32x2 gelu2(f32x2 x) {
    f32x2 xc; xc.x = __builtin_amdgcn_fmed3f(x.x, -3.5f, 3.5f); xc.y = __builtin_amdgcn_fmed3f(x.y, -3.5f, 3.5f);
    const f32x2 u = xc * xc;
    f32x2 p = u * (-8.701348406248144e-07f) + 4.0298804378835484e-05f; p = p * u + (-0.0007917149341665208f); p = p * u + 0.00885754730552435f; p = p * u + (-0.06504099816083908f); p = p * u + 0.3982582986354828f;
    return x * (xc * p + 0.5f);
}
__device__ __forceinline__ f32x2 gelu2x8(f32x2 x) {
    f32x2 xc; xc.x = __builtin_amdgcn_fmed3f(x.x, -3.5f, 3.5f); xc.y = __builtin_amdgcn_fmed3f(x.y, -3.5f, 3.5f);
    const f32x2 u = xc * xc;
    f32x2 p = u * (8.0f * -8.701348406248144e-07f) + (8.0f * 4.0298804378835484e-05f); p = p * u + (8.0f * -0.0007917149341665208f); p = p * u + (8.0f * 0.00885754730552435f); p = p * u + (8.0f * -0.06504099816083908f); p = p * u + (8.0f * 0.3982582986354828f);
    return x * (xc * p + 4.0f);
}
__device__ __forceinline__ f32x2 sig2(f32x2 g) {
    f32x2 gc; gc.x = __builtin_amdgcn_fmed3f(g.x, -7.0f, 7.0f); gc.y = __builtin_amdgcn_fmed3f(g.y, -7.0f, 7.0f);
    const f32x2 u = gc * gc;
    f32x2 p = u * 9.362564196147005e-11f + (-1.7167415933272423e-08f); p = p * u + 1.283512915506435e-06f; p = p * u + (-5.098102701595053e-05f); p = p * u + 0.0011952189961448312f; p = p * u + (-0.01824037730693817f); p = p * u + 0.247629314661026f;
    return gc * p + 0.5f;
}
__device__ __forceinline__ unsigned pk2(f32x2 v) { return cvt_pk_bf16(v.x, v.y); }
__device__ __forceinline__ unsigned pk4_fp8(float a, float b, float c, float d) {
    int w = 0;
    w = __builtin_amdgcn_cvt_pk_fp8_f32(__builtin_amdgcn_fmed3f(a, -448.f, 448.f), __builtin_amdgcn_fmed3f(b, -448.f, 448.f), w, false);
    w = __builtin_amdgcn_cvt_pk_fp8_f32(__builtin_amdgcn_fmed3f(c, -448.f, 448.f), __builtin_amdgcn_fmed3f(d, -448.f, 448.f), w, true);
    return (unsigned)w;
}
__device__ __forceinline__ void unpk4_fp8(unsigned w, float* o) { const f32x2 a = __builtin_amdgcn_cvt_pk_f32_fp8((int)w, false), b = __builtin_amdgcn_cvt_pk_f32_fp8((int)w, true); o[0] = a.x; o[1] = a.y; o[2] = b.x; o[3] = b.y; }
__device__ __forceinline__ unsigned pk4_fp8_nc(float a, float b, float c, float d) { int w = 0; w = __builtin_amdgcn_cvt_pk_fp8_f32(a, b, w, false); w = __builtin_amdgcn_cvt_pk_fp8_f32(c, d, w, true); return (unsigned)w; }
__device__ __forceinline__ u32x4 widen16(u32x2 X, u32x2 Y) {
    const auto r0 = __builtin_amdgcn_permlane16_swap(X.x, Y.x, false, false); const auto r1 = __builtin_amdgcn_permlane16_swap(X.y, Y.y, false, false);
    return (u32x4){r0[0], r1[0], r0[1], r1[1]};
}
constexpr float SC_WIN = 32.0f, SC_WOUT = 64.0f, SC_ACT = 8.0f, SC_Y = 16.0f, SC_BW = 32.0f, SC_YS = 8.0f, SC_AWO = 64.0f, SC_P = 4.0f, SC_AWI = 32.0f, SC_UV = 8.0f, SC_Z = 16.0f;
#define LO2(v) ((f32x2){(v)[0], (v)[1]})
#define HI2(v) ((f32x2){(v)[2], (v)[3]})

#define XB_TMO      128
#define XB_XCNT(j)  (256  + 64 * (j))
#define XB_XSUB(j)  (1280 + 64 * (j))
#define XB_XGEN(j)  (2304 + 64 * (j))
#define XB_TOP      3328
#define XB_TOPGEN   3392
#define XCD_BAR_WORDS 3456
#define XB_SPIN_CAP (1u << 18)
__device__ __forceinline__ unsigned xb_ld(unsigned* p)              { return __hip_atomic_load(p, __ATOMIC_RELAXED, __HIP_MEMORY_SCOPE_AGENT); }
__device__ __forceinline__ unsigned xb_add(unsigned* p, unsigned v) { return __hip_atomic_fetch_add(p, v, __ATOMIC_RELAXED, __HIP_MEMORY_SCOPE_AGENT); }
__device__ __forceinline__ unsigned xb_xcc_id() { return (unsigned)__builtin_amdgcn_s_getreg((3 << 11) | 20) & 0xFu; }
#define XB_SPIN(cond, bar) do { unsigned _sp = 0; while (cond) { __builtin_amdgcn_s_sleep(1); \
    if ((++_sp & 255u) == 0u) { if (xb_ld(&(bar)[XB_TMO])) break; if (_sp > XB_SPIN_CAP) { atomicAdd(&(bar)[XB_TMO], 1u); break; } } } } while (0)
struct XcdBarrier { unsigned* bar; unsigned x; volatile LAS unsigned* st; };
__device__ __forceinline__ XcdBarrier xcd_barrier_post(unsigned* bar, volatile LAS unsigned* st) {
    XcdBarrier b; b.bar = bar; b.x = xb_xcc_id(); b.st = st;
    if (threadIdx.x == 0) (void)xb_add(&bar[XB_XCNT(b.x)], 1u);
    return b;
}
__device__ __forceinline__ void xcd_barrier_complete(unsigned* bar, unsigned x, unsigned& nloc, unsigned& nx) {
    const unsigned G = gridDim.x * gridDim.y * gridDim.z;
    unsigned sum, cnt, mine, sp = 0u;
    for (;;) {
        sum = 0u; cnt = 0u; mine = 0u;
#pragma unroll
        for (unsigned j = 0; j < 16; ++j) { const unsigned c = xb_ld(&bar[XB_XCNT(j)]); sum += c; cnt += (c > 0u) ? 1u : 0u; mine = (j == x) ? c : mine; }
        if (sum == G) break;
        __builtin_amdgcn_s_sleep(1);
        if ((++sp & 255u) == 0u) { if (xb_ld(&bar[XB_TMO])) break; if (sp > XB_SPIN_CAP) { atomicAdd(&bar[XB_TMO], 1u); break; } }
    }
    nloc = mine > 0u ? mine : 1u; nx = cnt > 0u ? cnt : 1u;
}
__device__ __forceinline__ void xcd_barrier(const XcdBarrier& b) {
    asm volatile("s_waitcnt vmcnt(0)" ::: "memory");
    __syncthreads();
    if (threadIdx.x == 0) {
        unsigned* bar = b.bar;
        __builtin_amdgcn_s_waitcnt(0);
        unsigned nloc = b.st[0], nx = b.st[1];
        if (nloc == 0u) { xcd_barrier_complete(bar, b.x, nloc, nx); b.st[0] = nloc; b.st[1] = nx; }
        const unsigned old = xb_add(&bar[XB_XSUB(b.x)], 1u);
        const unsigned gen = old / nloc;
        if (old + 1u == (gen + 1u) * nloc) {
            __builtin_amdgcn_fence(__ATOMIC_RELEASE, "agent");
            asm volatile("s_waitcnt vmcnt(0)" ::: "memory");
            const unsigned og = xb_add(&bar[XB_TOP], 1u);
            const unsigned tg = og / nx;
            if (og + 1u == (tg + 1u) * nx) xb_add(&bar[XB_TOPGEN], 1u);
            else XB_SPIN(xb_ld(&bar[XB_TOPGEN]) == tg, bar);
            __builtin_amdgcn_fence(__ATOMIC_ACQUIRE, "agent");
            xb_add(&bar[XB_XGEN(b.x)], 1u);
            asm volatile("s_waitcnt vmcnt(0)" ::: "memory");
        } else {
            XB_SPIN(xb_ld(&bar[XB_XGEN(b.x)]) == gen, bar);
            __builtin_amdgcn_fence(__ATOMIC_ACQUIRE, "agent");
            asm volatile("s_waitcnt vmcnt(0)" ::: "memory");
        }
    }
    __syncthreads();
}

namespace pg8 {
constexpr int BM = 256, BK = 64, HALF = 128, HTB = HALF * BK * 2, STAGE_BYTES = 8 * HTB, NXCD = 8, WGM = 8;
__device__ __forceinline__ int lds_byte(int r, int c) { const int st = (r >> 4) * 2 + (c >> 5), rr = r & 15, cc = c & 31, ob = rr * 64 + cc * 2; return st * 1024 + (ob ^ (((ob >> 9) & 1) << 5)); }
__device__ __forceinline__ void stage_rc(int b, int& R, int& C) { const int st = b / 1024, sb = b % 1024, swz = sb ^ (((sb >> 9) & 1) << 5); R = (st >> 1) * 16 + swz / 64; C = (st & 1) * 32 + (swz % 64) / 2; }
__device__ __forceinline__ int perm32(int rho) { const int n = rho >> 4, i = rho & 15; return 8 * (i >> 2) + 4 * n + (i & 3); }

struct Unit { const char* a; const char* b; int x, y, z, w; };
typedef f32x4 Acc[2][2][4][2];

__device__ __forceinline__ bool static_unit(long L, int nM, int nN, int& pm, int& pn) {
    const int nwg = nM * nN; if (L >= nwg) return false;
    int wgid = (int)L; { const int q = nwg / NXCD, r = nwg % NXCD, xcd = wgid % NXCD, off = wgid / NXCD; wgid = (xcd < r ? xcd * (q + 1) : r * (q + 1) + (xcd - r) * q) + off; }
    const int nig = WGM * nN, gid = wgid / nig, fm = gid * WGM, gsz = (nM - fm) < WGM ? (nM - fm) : WGM;
    pm = fm + ((wgid % nig) % gsz); pn = (wgid % nig) / gsz; return true;
}

template <class G>
__device__ __forceinline__ void gemm_phase(LAS unsigned char* lds, const G& g) {
    const int tid = threadIdx.x, wid = __builtin_amdgcn_readfirstlane(tid >> 6), lane = tid & 63, wr = wid >> 2, wc = wid & 3, fr = lane & 15, fq = lane >> 4;
    const int nt = g.nt;
    unsigned voffB[2], vA0[2], vA1[2], nA0[2], nA1[2]; int Rl[2], Cl[2];
#pragma unroll
    for (int i = 0; i < 2; ++i) { int R, C; stage_rc(tid * 16 + i * 8192, R, C); const int Rb = (G::PERMK == 2) ? (64 * (R >> 5) + 16 * ((R & 15) >> 2) + 4 * ((R >> 4) & 1) + (R & 3)) : (G::PERMK == 1) ? ((R & ~31) + perm32(R & 31)) : R;
        Rl[i] = R; Cl[i] = C; voffB[i] = g.voffB(Rb, C); }
    const size_t kstepA = g.kstepA, kstepB = g.kstepB, hstepB = g.hstepB;
    const unsigned ldsw = (unsigned)wid * 1024u;
    const int aoff = lds_byte(wr * 64 + fr, fq * 8), boff = lds_byte(wc * 32 + fr, fq * 8);
#define PG8_SA(b, h) (((b) * 2 + (h)) * HTB)
#define PG8_SB(b, h) ((4 + (b) * 2 + (h)) * HTB)
#define PG8_STAGE(bufoff, gbase, voff) do { _Pragma("unroll") for (int _i = 0; _i < 2; ++_i) \
        __builtin_amdgcn_global_load_lds((const unsigned*)((const char*)(gbase) + (voff)[_i]), (LAS unsigned*)(lds + (bufoff) + ldsw + _i * 8192), 16, 0, 0); } while (0)
#define PG8_LDA(dst, b, h) do { _Pragma("unroll") for (int m = 0; m < 4; ++m) _Pragma("unroll") for (int k = 0; k < 2; ++k) dst[m][k] = *(const LAS i32x4*)(lds + PG8_SA(b, h) + aoff + m * 2048 + k * 1024); } while (0)
#define PG8_LDB(dst, b, h) do { _Pragma("unroll") for (int n = 0; n < 2; ++n) _Pragma("unroll") for (int k = 0; k < 2; ++k) dst[n][k] = *(const LAS i32x4*)(lds + PG8_SB(b, h) + boff + n * 2048 + k * 1024); } while (0)
#define PG8_CAT(f) __builtin_shufflevector((f)[0], (f)[1], 0, 1, 2, 3, 4, 5, 6, 7)
#define PG8_MMA(ai, bj, At, Bt) do { __builtin_amdgcn_s_setprio(1); \
        if constexpr (G::FP8) { _Pragma("unroll") for (int m = 0; m < 4; ++m) _Pragma("unroll") for (int n = 0; n < 2; ++n) \
            asm volatile("v_mfma_scale_f32_16x16x128_f8f6f4 %0, %1, %2, %0, %3, %3 op_sel_hi:[0,0,0]" : "+v"(acc[ai][bj][m][n]) : "v"(PG8_CAT(Bt[n])), "v"(PG8_CAT(At[m])), "v"(sc1)); } \
        else { _Pragma("unroll") for (int m = 0; m < 4; ++m) _Pragma("unroll") for (int n = 0; n < 2; ++n) _Pragma("unroll") for (int k = 0; k < 2; ++k) \
            acc[ai][bj][m][n] = __builtin_amdgcn_mfma_f32_16x16x32_bf16(__builtin_bit_cast(bf16x8, Bt[n][k]), __builtin_bit_cast(bf16x8, At[m][k]), acc[ai][bj][m][n], 0, 0, 0); } \
        __builtin_amdgcn_s_setprio(0); } while (0)
#define PG8_WAIT_V(n) asm volatile("s_waitcnt vmcnt(" #n ")" ::: "memory")
#define PG8_WAIT_L(n) asm volatile("s_waitcnt lgkmcnt(" #n ")" ::: "memory")
#define PG8_BAR __builtin_amdgcn_s_barrier()
#define PG8_SCHED __builtin_amdgcn_sched_barrier(0)
    Unit cur, nxt; int ui = 0;
    if (!g.next(0, cur)) return;
    Acc acc;
#pragma unroll
    for (int a = 0; a < 2; ++a)
#pragma unroll
        for (int b = 0; b < 2; ++b)
#pragma unroll
            for (int m = 0; m < 4; ++m)
#pragma unroll
                for (int n = 0; n < 2; ++n) acc[a][b][m][n] = (f32x4){0.f, 0.f, 0.f, 0.f};
    i32x4 At[4][2], B0[2][2], B1[2][2];
    const int sc1 = 0x7f7f7f7f;
    const char* cA = cur.a; const char* cB = cur.b;
#pragma unroll
    for (int i = 0; i < 2; ++i) {
        if constexpr (G::GATHER) { vA0[i] = g.gatherA(0, Rl[i], Cl[i], 0); vA1[i] = g.gatherA(0, Rl[i], Cl[i], 1); }
        else { vA0[i] = g.voffA(Rl[i], Cl[i], 0); vA1[i] = g.voffA(Rl[i], Cl[i], 1); }
        nA0[i] = vA0[i]; nA1[i] = vA1[i];
    }
    PG8_STAGE(PG8_SB(0, 0), cB, voffB); PG8_STAGE(PG8_SB(0, 1), cB + hstepB, voffB); PG8_STAGE(PG8_SA(0, 0), cA, vA0); PG8_STAGE(PG8_SA(0, 1), cA, vA1);
    if (wr == 1) PG8_BAR;
    PG8_WAIT_V(2); PG8_BAR;
    PG8_STAGE(PG8_SB(1, 0), cB + kstepB, voffB); PG8_STAGE(PG8_SA(1, 0), cA + kstepA, vA0); PG8_STAGE(PG8_SB(1, 1), cB + hstepB + kstepB, voffB);
    PG8_WAIT_V(6); PG8_BAR;
    for (;;) {
        const bool has_next = g.next(ui + 1, nxt);
        const char* nA = has_next ? nxt.a : cA; const char* nB = has_next ? nxt.b : cB;
        for (int t = 0; t < nt; t += 2) {
            const bool last = (t == nt - 2);
            const char* a1 = cA + (size_t)(t + 1) * kstepA;
            const char* a2 = last ? nA : cA + (size_t)(t + 2) * kstepA; const char* b2 = last ? nB : cB + (size_t)(t + 2) * kstepB;
            const char* a3 = a2 + kstepA; const char* b3 = b2 + kstepB;
            unsigned s0[2], s1[2];
            if constexpr (G::GATHER) {
                if (last && has_next) {
#pragma unroll
                    for (int i = 0; i < 2; ++i) { nA0[i] = g.gatherA(ui + 1, Rl[i], Cl[i], 0); nA1[i] = g.gatherA(ui + 1, Rl[i], Cl[i], 1); }
                }
#pragma unroll
                for (int i = 0; i < 2; ++i) { s0[i] = last ? nA0[i] : vA0[i]; s1[i] = last ? nA1[i] : vA1[i]; }
            } else {
#pragma unroll
                for (int i = 0; i < 2; ++i) { s0[i] = vA0[i]; s1[i] = vA1[i]; }
            }
            PG8_LDB(B0, 0, 0); PG8_LDB(B1, 0, 1); PG8_SCHED; PG8_LDA(At, 0, 0); PG8_STAGE(PG8_SA(1, 1), a1, vA1);
            PG8_WAIT_V(8); PG8_WAIT_L(0); PG8_BAR; PG8_MMA(0, 0, At, B0); PG8_MMA(0, 1, At, B1); PG8_BAR; PG8_SCHED;
            PG8_LDA(At, 0, 1); PG8_STAGE(PG8_SB(0, 0), b2, voffB); PG8_STAGE(PG8_SB(0, 1), b2 + hstepB, voffB); PG8_STAGE(PG8_SA(0, 0), a2, s0);
            PG8_WAIT_V(8); PG8_WAIT_L(0); PG8_BAR; PG8_MMA(1, 0, At, B0); PG8_MMA(1, 1, At, B1); PG8_BAR; PG8_SCHED;
            PG8_LDB(B0, 1, 0); PG8_LDB(B1, 1, 1); PG8_SCHED; PG8_LDA(At, 1, 0); PG8_STAGE(PG8_SA(0, 1), a2, s1);
            PG8_WAIT_V(8); PG8_WAIT_L(0); PG8_BAR; PG8_MMA(0, 0, At, B0); PG8_MMA(0, 1, At, B1); PG8_BAR; PG8_SCHED;
            PG8_LDA(At, 1, 1); PG8_STAGE(PG8_SB(1, 0), b3, voffB); PG8_STAGE(PG8_SB(1, 1), b3 + hstepB, voffB); PG8_STAGE(PG8_SA(1, 0), a3, s0);
            PG8_WAIT_V(8); PG8_WAIT_L(0); PG8_BAR; PG8_MMA(1, 0, At, B0); PG8_MMA(1, 1, At, B1); PG8_BAR; PG8_SCHED;
        }
        if (wr == 0) PG8_BAR;
        if constexpr (G::FP8) asm volatile("s_nop 15\n\ts_nop 15\n\ts_nop 15" ::: "memory");
        if (!g.nostore) g.epi(acc, cur, wr, wc, fr, fq);
        if (!has_next) break;
#pragma unroll
        for (int a = 0; a < 2; ++a)
#pragma unroll
            for (int b = 0; b < 2; ++b)
#pragma unroll
                for (int m = 0; m < 4; ++m)
#pragma unroll
                    for (int n = 0; n < 2; ++n) acc[a][b][m][n] = (f32x4){0.f, 0.f, 0.f, 0.f};
        cur = nxt; cA = nA; cB = nB; ++ui;
#pragma unroll
        for (int i = 0; i < 2; ++i) { vA0[i] = nA0[i]; vA1[i] = nA1[i]; }
        if (wr == 1) PG8_BAR;
    }
    PG8_WAIT_V(0);
    PG8_BAR;
#undef PG8_SA
#undef PG8_SB
#undef PG8_STAGE
#undef PG8_LDA
#undef PG8_LDB
#undef PG8_MMA
#undef PG8_CAT
#undef PG8_WAIT_V
#undef PG8_WAIT_L
#undef PG8_BAR
#undef PG8_SCHED
}
}

struct GemmBase {
    static constexpr bool GATHER = false, FP8 = false; static constexpr int PERMK = 1;
    int nt; unsigned kstepA, kstepB; size_t hstepB; int G, c; int nostore = 0;
    unsigned lda2, hstepA, ldb2;
    __device__ __forceinline__ unsigned voffA(int R, int C, int h) const { return (unsigned)R * lda2 + (unsigned)C * 2u + (unsigned)h * hstepA; }
    __device__ __forceinline__ unsigned voffB(int Rb, int C) const { return (unsigned)Rb * ldb2 + (unsigned)C * 2u; }
    __device__ __forceinline__ unsigned gatherA(int, int, int, int) const { return 0u; }
    __device__ __forceinline__ void init_bytes(int Kbytes, int lda_bytes, int G_, int c_) {
        nt = Kbytes / 128; kstepA = 128u; kstepB = 128u; ldb2 = (unsigned)Kbytes; hstepB = (size_t)128 * Kbytes; lda2 = (unsigned)lda_bytes; hstepA = 128u * lda2; G = G_; c = c_; }
    __device__ __forceinline__ void init_plain(int K, int lda_elems, int G_, int c_) {
        nt = K / 64; kstepA = 128u; kstepB = 128u; ldb2 = (unsigned)K * 2u; hstepB = (size_t)128 * K * 2; lda2 = (unsigned)lda_elems * 2u; hstepA = 128u * lda2; G = G_; c = c_; }
};

struct GemmG1 : GemmBase {
    static constexpr bool FP8 = true; static constexpr int PERMK = 2;
    const unsigned char* A; const unsigned char* Bt; unsigned char* O; const float* bias;
    __device__ __forceinline__ bool next(int i, pg8::Unit& u) const { int pm, pn; if (!pg8::static_unit((long)i * G + c, NTOK / 256, 16, pm, pn)) return false;
        u.a = (const char*)A + (size_t)pm * 256 * D; u.b = (const char*)Bt + (size_t)pn * 256 * D; u.x = pm; u.y = pn; return true; }
    __device__ __forceinline__ void epi(const pg8::Acc& acc, const pg8::Unit& u, int wr, int wc, int fr, int fq) const {
        const int row0 = u.x * 256 + wr * 64 + fr, col0 = u.y * 256 + wc * 64 + 16 * fq;
        constexpr float SA = 1.0f / SC_AWI;
        f32x4 bv[2][2];
#pragma unroll
        for (int bj = 0; bj < 2; ++bj)
#pragma unroll
            for (int n = 0; n < 2; ++n) bv[bj][n] = *(const f32x4*)(bias + col0 + 8 * bj + 4 * n);
#pragma unroll
        for (int ai = 0; ai < 2; ++ai)
#pragma unroll
            for (int m = 0; m < 4; ++m) { u32x4 w;
#pragma unroll
                for (int bj = 0; bj < 2; ++bj) { const f32x4 v0 = acc[ai][bj][m][0] * SA + bv[bj][0], v1 = acc[ai][bj][m][1] * SA + bv[bj][1];
                    static_assert(SC_UV == 8.0f, "gelu2x8"); const f32x2 r0 = gelu2x8(LO2(v0)), r1 = gelu2x8(HI2(v0)), r2 = gelu2x8(LO2(v1)), r3 = gelu2x8(HI2(v1));
                    w[2 * bj] = pk4_fp8_nc(r0.x, r0.y, r1.x, r1.y); w[2 * bj + 1] = pk4_fp8_nc(r2.x, r2.y, r3.x, r3.y); }
                *(u32x4*)(O + (size_t)(row0 + ai * 128 + m * 16) * 4096 + col0) = w; }
    }
};

struct GemmG3 : GemmBase {
    static constexpr bool FP8 = true; static constexpr int PERMK = 2;
    const unsigned char* A; const unsigned char* Bt; bf16_t* Z; const bf16_t* R;
    __device__ __forceinline__ bool next(int i, pg8::Unit& u) const { int pm, pn; if (!pg8::static_unit((long)i * G + c, NTOK / 256, 8, pm, pn)) return false;
        u.a = (const char*)A + (size_t)pm * 256 * D; u.b = (const char*)Bt + (size_t)pn * 256 * D; u.x = pm; u.y = pn; return true; }
    __device__ __forceinline__ void epi(const pg8::Acc& acc, const pg8::Unit& u, int wr, int wc, int fr, int fq) const {
        const int row0 = u.x * 256 + wr * 64 + fr, col0 = u.y * 256 + wc * 64 + 16 * fq;
        constexpr float SM = SC_Z / (SC_P * SC_AWO);
        unsigned char* Z8 = (unsigned char*)Z;
#pragma unroll
        for (int ai = 0; ai < 2; ++ai)
#pragma unroll
            for (int m = 0; m < 4; ++m) { u32x4 w;
#pragma unroll
                for (int bj = 0; bj < 2; ++bj) { const f32x4 v0 = acc[ai][bj][m][0] * SM, v1 = acc[ai][bj][m][1] * SM; w[2 * bj] = pk4_fp8_nc(v0[0], v0[1], v0[2], v0[3]); w[2 * bj + 1] = pk4_fp8_nc(v1[0], v1[1], v1[2], v1[3]); }
                *(u32x4*)(Z8 + (size_t)(row0 + ai * 128 + m * 16) * D + col0) = w; }
    }
};

struct GemmS1 : GemmBase {
    static constexpr bool FP8 = true; static constexpr int PERMK = 2;
    const unsigned char* A; const unsigned char* Bt; bf16_t* A2;
    __device__ __forceinline__ bool next(int i, pg8::Unit& u) const { int pm, pn; if (!pg8::static_unit((long)i * G + c, NTOK / 256, 4, pm, pn)) return false;
        u.a = (const char*)A + (size_t)pm * 256 * D; u.b = (const char*)Bt + (size_t)pn * 256 * D; u.x = pm; u.y = pn; return true; }
    __device__ __forceinline__ void epi(const pg8::Acc& acc, const pg8::Unit& u, int wr, int wc, int fr, int fq) const {
        const int row0 = u.x * 256 + wr * 64 + fr, col0 = u.y * 256 + wc * 64 + 16 * fq;
        constexpr float SU = 1.0f / SC_BW;
        const int gg = col0 >> 4;
#pragma unroll
        for (int ai = 0; ai < 2; ++ai)
#pragma unroll
            for (int m = 0; m < 4; ++m) { const int tok = row0 + ai * 128 + m * 16; const int rr = tok >> 4, ii = tok & 15; bf16_t* dst = A2 + ((size_t)gg * 2048 + rr) * 384 + ii * 16;
#pragma unroll
                for (int bj = 0; bj < 2; ++bj) { const f32x4 v0 = acc[ai][bj][m][0] * SU, v1 = acc[ai][bj][m][1] * SU;
                    u32x4 w; w.x = cvt_pk_bf16(v0[0], v0[1]); w.y = cvt_pk_bf16(v0[2], v0[3]); w.z = cvt_pk_bf16(v1[0], v1[1]); w.w = cvt_pk_bf16(v1[2], v1[3]);
                    *(u32x4*)(dst + bj * 8) = w; } }
    }
};

struct GemmS2 : GemmBase {
    static constexpr int PERMK = 0;
    const bf16_t* A2; const bf16_t* Et; float* Xend;
    __device__ __forceinline__ bool next(int i, pg8::Unit& u) const { const long v = (long)i * G + c; if (v >= 512) return false; const int gg = (int)(v >> 3), pm = (int)(v & 7);
        u.a = (const char*)A2 + ((size_t)gg * 2048 + pm * 256) * 384 * 2; u.b = (const char*)Et + (size_t)gg * 256 * 256 * 2; u.x = gg; u.y = pm; return true; }
    __device__ __forceinline__ void epi(const pg8::Acc& acc, const pg8::Unit& u, int wr, int wc, int fr, int fq) const {
        const int row0 = u.y * 256 + wr * 64 + fr, col0 = wc * 32 + 4 * fq;
#pragma unroll
        for (int ai = 0; ai < 2; ++ai)
#pragma unroll
            for (int m = 0; m < 4; ++m) { float* rowp = Xend + ((size_t)u.x * 2048 + row0 + ai * 128 + m * 16) * 128 + col0;
#pragma unroll
                for (int n = 0; n < 2; ++n) *(f32x4*)(rowp + n * 16) = acc[ai][0][m][n]; }
    }
};

struct GemmS4 : GemmBase {
    static constexpr int PERMK = 2;
    const bf16_t* A2; const bf16_t* Bs; unsigned char* Y;
    __device__ __forceinline__ bool next(int i, pg8::Unit& u) const { const long v = (long)i * G + c; if (v >= 512) return false; const int gg = (int)(v >> 3), pm = (int)(v & 7);
        u.a = (const char*)A2 + ((size_t)gg * 2048 + pm * 256) * 384 * 2; u.b = (const char*)Bs + (size_t)gg * 256 * 384 * 2; u.x = gg; u.y = pm; return true; }
    __device__ __forceinline__ void epi(const pg8::Acc& acc, const pg8::Unit& u, int wr, int wc, int fr, int fq) const {
        const int row0 = u.y * 256 + wr * 64 + fr, col0 = wc * 64 + 16 * fq;
#pragma unroll
        for (int ai = 0; ai < 2; ++ai)
#pragma unroll
            for (int m = 0; m < 4; ++m) { u32x4 w;
#pragma unroll
                for (int bj = 0; bj < 2; ++bj) { const f32x4 v0 = acc[ai][bj][m][0], v1 = acc[ai][bj][m][1];
                    static_assert(SC_YS == 8.0f, "gelu2x8"); const f32x2 r0 = gelu2x8(LO2(v0)), r1 = gelu2x8(HI2(v0)), r2 = gelu2x8(LO2(v1)), r3 = gelu2x8(HI2(v1));
                    w[2 * bj] = pk4_fp8_nc(r0.x, r0.y, r1.x, r1.y); w[2 * bj + 1] = pk4_fp8_nc(r2.x, r2.y, r3.x, r3.y); }
                *(u32x4*)(Y + ((size_t)u.x * 2048 + row0 + ai * 128 + m * 16) * 256 + col0) = w; }
    }
};

struct GemmS5 : GemmBase {
    static constexpr bool FP8 = true;
    const unsigned char* Y; const unsigned char* Bt; bf16_t* Z; const bf16_t* R;
    __device__ __forceinline__ unsigned voffA(int Rr, int C, int h) const { return (unsigned)((C >> 3) * 2048 * 256 + (Rr >> 4) * 256 + (Rr & 15) * 16 + h * 2048); }
    __device__ __forceinline__ bool next(int i, pg8::Unit& u) const { int pm, pn; if (!pg8::static_unit((long)i * G + c, NTOK / 256, 16, pm, pn)) return false;
        u.a = (const char*)Y + (size_t)pm * 16 * 256; u.b = (const char*)Bt + (size_t)pn * 256 * BW; u.x = pm; u.y = pn; return true; }
    __device__ __forceinline__ void epi(const pg8::Acc& acc, const pg8::Unit& u, int wr, int wc, int fr, int fq) const {
        const int row0 = u.x * 256 + wr * 64 + fr + 16 * (fq & 1), col0 = u.y * 128 + wc * 32 + 16 * (fq >> 1);
        constexpr float SV = 1.0f / (SC_YS * SC_BW);
#pragma unroll
        for (int ai = 0; ai < 2; ++ai) { u32x2 w[4];
#pragma unroll
            for (int m = 0; m < 4; ++m) {
                const f32x4 a0 = acc[ai][0][m][0] * SV, a1 = acc[ai][0][m][1] * SV, g0 = acc[ai][1][m][0] * SV, g1 = acc[ai][1][m][1] * SV;
                const f32x2 r0 = LO2(a0) * sig2(LO2(g0)) * SC_Z, r1 = HI2(a0) * sig2(HI2(g0)) * SC_Z, r2 = LO2(a1) * sig2(LO2(g1)) * SC_Z, r3 = HI2(a1) * sig2(HI2(g1)) * SC_Z;
                w[m].x = pk4_fp8_nc(r0.x, r0.y, r1.x, r1.y); w[m].y = pk4_fp8_nc(r2.x, r2.y, r3.x, r3.y); }
#pragma unroll
            for (int mp = 0; mp < 2; ++mp) *(u32x4*)((unsigned char*)Z + (size_t)(row0 + ai * 128 + mp * 32) * D + col0) = widen16(w[2 * mp], w[2 * mp + 1]); }
    }
};

struct MoeTab { const LAS int* tp; const LAS int* sb; const LAS int* cnt; int nU; };
__device__ __forceinline__ bool moe_unit(const MoeTab& T, long L, int& e, int& mt, int& pn) {
    const int nU = T.nU; if (L >= nU) return false;
    int v; { const int q = nU / 8, r = nU % 8, xcd = (int)(L % 8), off = (int)(L / 8); v = (xcd < r ? xcd * (q + 1) : r * (q + 1) + (xcd - r) * q) + off; }
    const int tile = v >> 3;
    int ee = 0;
#pragma unroll
    for (int j = 1; j < 16; ++j) ee += (tile >= __builtin_amdgcn_readfirstlane(T.tp[j])) ? 1 : 0;
    const int tp0 = __builtin_amdgcn_readfirstlane(T.tp[ee]), tp1 = __builtin_amdgcn_readfirstlane(T.tp[ee + 1]);
    const int tiles_e = tp1 - tp0, ve = v - 8 * tp0;
    const int gid = ve >> 6, fm = gid * 8, gsz = (tiles_e - fm) < 8 ? (tiles_e - fm) : 8, rem = ve - 64 * gid;
    e = ee; mt = fm + rem % gsz; pn = rem / gsz; return true;
}

struct GemmM1 : GemmBase {
    static constexpr bool GATHER = true, FP8 = true;
    const unsigned char* H8; const unsigned char* Bt; unsigned char* ACT; MoeTab T; const LAS int* rows;
    __device__ __forceinline__ unsigned gatherA(int ui, int Rr, int C, int h) const { return (unsigned)rows[ui * 256 + h * 128 + Rr] * (unsigned)D + (unsigned)C * 2u; }
    __device__ __forceinline__ bool next(int i, pg8::Unit& u) const { int e, mt, pn; if (!moe_unit(T, (long)i * G + c, e, mt, pn)) return false;
        u.a = (const char*)H8; u.b = (const char*)Bt + ((size_t)e * 2048 + pn * 256) * D; u.x = __builtin_amdgcn_readfirstlane(T.sb[e]) + mt * 256; u.y = pn; u.z = e; u.w = mt; return true; }
    __device__ __forceinline__ void epi(const pg8::Acc& acc, const pg8::Unit& u, int wr, int wc, int fr, int fq) const {
        const int row0 = u.x + wr * 64 + fr + 16 * (fq & 1), col0 = u.y * 128 + wc * 32 + 16 * (fq >> 1);
        constexpr float SG = 1.0f / SC_WIN, SU = SC_ACT / SC_WIN;
#pragma unroll
        for (int ai = 0; ai < 2; ++ai) { u32x2 w[4];
#pragma unroll
            for (int m = 0; m < 4; ++m) { const f32x4 a0 = acc[ai][0][m][0] * SG, a1 = acc[ai][0][m][1] * SG, u0 = acc[ai][1][m][0] * SU, u1 = acc[ai][1][m][1] * SU;
                const f32x2 r0 = LO2(a0) * sig2(LO2(a0)) * LO2(u0), r1 = HI2(a0) * sig2(HI2(a0)) * HI2(u0), r2 = LO2(a1) * sig2(LO2(a1)) * LO2(u1), r3 = HI2(a1) * sig2(HI2(a1)) * HI2(u1);
                w[m].x = pk4_fp8(r0.x, r0.y, r1.x, r1.y); w[m].y = pk4_fp8(r2.x, r2.y, r3.x, r3.y); }
#pragma unroll
            for (int mp = 0; mp < 2; ++mp) *(u32x4*)(ACT + (size_t)(row0 + ai * 128 + mp * 32) * DFF + col0) = widen16(w[2 * mp], w[2 * mp + 1]); }
    }
};
struct GemmM2 : GemmBase {
    static constexpr bool FP8 = true; static constexpr int PERMK = 2;
    const unsigned char* ACT; const unsigned char* Bt; unsigned char* YB; MoeTab T;
    __device__ __forceinline__ bool next(int i, pg8::Unit& u) const { int e, mt, pn; if (!moe_unit(T, (long)i * G + c, e, mt, pn)) return false;
        const int r0 = __builtin_amdgcn_readfirstlane(T.sb[e]) + mt * 256; u.a = (const char*)ACT + (size_t)r0 * DFF; u.b = (const char*)Bt + ((size_t)e * 2048 + pn * 256) * DFF; u.x = r0; u.y = pn; return true; }
    __device__ __forceinline__ void epi(const pg8::Acc& acc, const pg8::Unit& u, int wr, int wc, int fr, int fq) const {
        const int row0 = u.x + wr * 64 + fr, col0 = u.y * 256 + wc * 64 + 16 * fq;
        constexpr float SY = SC_Y / (SC_ACT * SC_WOUT);
#pragma unroll
        for (int ai = 0; ai < 2; ++ai)
#pragma unroll
            for (int m = 0; m < 4; ++m) { u32x4 w;
#pragma unroll
                for (int bj = 0; bj < 2; ++bj) { const f32x4 v0 = acc[ai][bj][m][0] * SY, v1 = acc[ai][bj][m][1] * SY;
                    w[2 * bj] = pk4_fp8_nc(v0[0], v0[1], v0[2], v0[3]); w[2 * bj + 1] = pk4_fp8_nc(v1[0], v1[1], v1[2], v1[3]); }
                *(u32x4*)(YB + (size_t)(row0 + ai * 128 + m * 16) * D + col0) = w; }
    }
};

struct Args { const float* in[26]; float* out; unsigned char* ws; int ph_lo, ph_hi, flags, pad; };
struct Frame {
    LAS unsigned char* lds; unsigned char* ws; unsigned* ctl;
    int tid, lane, wave, G, bx;
};

__device__ __forceinline__ void transpose_item(const float* __restrict__ src, int ldsrc, int k0, int srccol0, bf16_t* __restrict__ dst, int ldt, int dstrow0, LAS unsigned char* scr, int tid) {
    const int a = tid >> 5, nq = tid & 31;
    f32x4 v[8];
#pragma unroll
    for (int r = 0; r < 8; ++r) v[r] = *(const f32x4*)(src + (size_t)(k0 + 8 * a + r) * ldsrc + srccol0 + 4 * nq);
#pragma unroll
    for (int j = 0; j < 4; ++j) { u32x4 w; w.x = cvt_pk_bf16(v[0][j], v[1][j]); w.y = cvt_pk_bf16(v[2][j], v[3][j]); w.z = cvt_pk_bf16(v[4][j], v[5][j]); w.w = cvt_pk_bf16(v[6][j], v[7][j]);
        const int n = 4 * nq + j; *(LAS u32x4*)(scr + n * 256 + ((a ^ ((n >> 2) & 15)) << 4)) = w; }
    __syncthreads();
#pragma unroll
    for (int q = 0; q < 4; ++q) { const int idx = tid + 512 * q, n = idx >> 4, ch = idx & 15;
        const u32x4 w = *(const LAS u32x4*)(scr + n * 256 + ((ch ^ ((n >> 2) & 15)) << 4));
        *(u32x4*)(dst + (size_t)(dstrow0 + n) * ldt + k0 + 8 * ch) = w; }
    __syncthreads();
}
__device__ __forceinline__ void transpose_item_f8(const float* __restrict__ src, int ldsrc, int k0, int srccol0, unsigned char* __restrict__ dst, int ldt, int dstrow0, float sc, LAS unsigned char* scr, int tid) {
    const int a = tid >> 5, nq = tid & 31;
#pragma unroll
    for (int h = 0; h < 2; ++h) {
        f32x4 v[8];
#pragma unroll
        for (int r = 0; r < 8; ++r) v[r] = *(const f32x4*)(src + (size_t)(k0 + 128 * h + 8 * a + r) * ldsrc + srccol0 + 4 * nq) * sc;
#pragma unroll
        for (int j = 0; j < 4; ++j) { u32x2 w; w.x = pk4_fp8(v[0][j], v[1][j], v[2][j], v[3][j]); w.y = pk4_fp8(v[4][j], v[5][j], v[6][j], v[7][j]);
            const int n = 4 * nq + j, c16 = 8 * h + (a >> 1); *(LAS u32x2*)(scr + n * 256 + ((c16 ^ ((n >> 2) & 15)) << 4) + (a & 1) * 8) = w; }
    }
    __syncthreads();
#pragma unroll
    for (int q = 0; q < 4; ++q) { const int idx = tid + 512 * q, n = idx >> 4, ch = idx & 15;
        const u32x4 w = *(const LAS u32x4*)(scr + n * 256 + ((ch ^ ((n >> 2) & 15)) << 4));
        *(u32x4*)(dst + (size_t)(dstrow0 + n) * ldt + k0 + 16 * ch) = w; }
    __syncthreads();
}
__device__ __forceinline__ void transpose_job_f8(Frame& F, const float* src, unsigned char* dst, int nmat, int K, int N, bool glu, float sc, int& itbase) {
    const int kb = K / 256, nb = N / 128, per = kb * nb, total = nmat * per;
    int first = (F.bx - itbase % F.G + F.G) % F.G;
    for (int it = first; it < total; it += F.G) {
        const int m = it / per, r = it % per, kk = r / nb, nn = r % nb;
        const int srccol0 = glu ? ((nn & 1) * (N / 2) + (nn >> 1) * 128) : nn * 128;
        transpose_item_f8(src + (size_t)m * K * N, N, kk * 256, srccol0, dst + (size_t)m * K * N, K, nn * 128, sc, F.lds, F.tid);
    }
    itbase += total;
}
__device__ __forceinline__ void transpose_job(Frame& F, const float* src, bf16_t* dst, int nmat, int K, int N, bool glu, int& itbase) {
    const int kb = K / 128, nb = N / 128, per = kb * nb, total = nmat * per;
    int first = (F.bx - itbase % F.G + F.G) % F.G;
    for (int it = first; it < total; it += F.G) {
        const int m = it / per, r = it % per, kk = r / nb, nn = r % nb;
        const int srccol0 = glu ? ((nn & 1) * (N / 2) + (nn >> 1) * 128) : nn * 128;
        transpose_item(src + (size_t)m * K * N, N, kk * 128, srccol0, dst + (size_t)m * K * N, K, nn * 128, F.lds, F.tid);
    }
    itbase += total;
}

__device__ __forceinline__ void ssm_precompute(Frame& F, const float* const* in, int g) {
    const float* a_re = in[9]; const float* a_im = in[10]; const float* log_dt = in[11]; const float* b_re = in[12]; const float* b_im = in[13];
    const float* c_re = in[14]; const float* c_im = in[15]; const float* dsk = in[16];
    LAS float* PW = (LAS float*)F.lds;
    LAS float* BB = PW + 64 * 17 * 2;
    LAS float* CC = BB + 64 * 16 * 2;
    LAS float* KM = CC + 16 * 64 * 2;
    bf16_t* Bs = (bf16_t*)(F.ws + WS_SSMB) + (size_t)g * 256 * 384;
    bf16_t* Et = (bf16_t*)(F.ws + WS_SSME) + (size_t)g * 256 * 256;
    const float dt = expf(log_dt[g]);
    __syncthreads();
    for (int idx = F.tid; idx < 64 * 17; idx += NTHR) { const int p = idx / 17, k = idx % 17; const float zr = a_re[g * 64 + p] * dt * (float)k, zi = a_im[g * 64 + p] * dt * (float)k;
        const float mag = expf(zr); float sn, cs; sincosf(zi, &sn, &cs); PW[idx * 2] = mag * cs; PW[idx * 2 + 1] = mag * sn; }
    for (int idx = F.tid; idx < 64 * 16; idx += NTHR) { const int p = idx >> 4, c = idx & 15; const float ar = a_re[g * 64 + p], ai = a_im[g * 64 + p];
        const float zr = ar * dt, zi = ai * dt; const float mag = expf(zr); float sn, cs; sincosf(zi, &sn, &cs);
        const float nr = mag * cs - 1.0f, ni = mag * sn;
        const float den = 1.0f / (ar * ar + ai * ai); const float qr = (nr * ar + ni * ai) * den, qi = (ni * ar - nr * ai) * den;
        const float br = b_re[(g * 64 + p) * 16 + c], bi = b_im[(g * 64 + p) * 16 + c];
        BB[idx * 2] = qr * br - qi * bi; BB[idx * 2 + 1] = qr * bi + qi * br; }
    for (int idx = F.tid; idx < 16 * 64; idx += NTHR) { const int c = idx >> 6, p = idx & 63; CC[idx * 2] = c_re[(g * 16 + c) * 64 + p]; CC[idx * 2 + 1] = c_im[(g * 16 + c) * 64 + p]; }
    __syncthreads();
    for (int idx = F.tid; idx < 4096; idx += NTHR) { const int k = idx >> 8, c = (idx >> 4) & 15, cp = idx & 15; float s = 0.f;
        for (int p = 0; p < 64; ++p) { const float cr = CC[(c * 64 + p) * 2], ci = CC[(c * 64 + p) * 2 + 1], pr = PW[(p * 17 + k) * 2], pi = PW[(p * 17 + k) * 2 + 1], br = BB[(p * 16 + cp) * 2], bi = BB[(p * 16 + cp) * 2 + 1];
            const float tr = cr * pr - ci * pi, ti = cr * pi + ci * pr; s += tr * br - ti * bi; }
        KM[idx] = s; }
    __syncthreads();
    for (int idx = F.tid; idx < 256 * 256; idx += NTHR) { const int n = idx >> 8, kq = idx & 255, i = n >> 4, c = n & 15, ip = kq >> 4, cp = kq & 15;
        float v = 0.f; if (ip <= i) v = KM[((i - ip) * 16 + c) * 16 + cp]; if (ip == i && c == cp) v += dsk[g * 16 + c];
        Bs[(size_t)n * 384 + kq] = (bf16_t)f2bf(v); }
    for (int idx = F.tid; idx < 256 * 64; idx += NTHR) { const int n = idx >> 6, p = idx & 63, i = n >> 4, c = n & 15;
        const float cr = CC[(c * 64 + p) * 2], ci = CC[(c * 64 + p) * 2 + 1], pr = PW[(p * 17 + i + 1) * 2], pi = PW[(p * 17 + i + 1) * 2 + 1];
        Bs[(size_t)n * 384 + 256 + p] = (bf16_t)f2bf(cr * pr - ci * pi); Bs[(size_t)n * 384 + 320 + p] = (bf16_t)f2bf(-(cr * pi + ci * pr)); }
    for (int idx = F.tid; idx < 256 * 256; idx += NTHR) { const int n = idx >> 8, kq = idx & 255, ip = kq >> 4, cp = kq & 15; float v = 0.f;
        if (n < 128) { const int p = n & 63; const float pr = PW[(p * 17 + 15 - ip) * 2], pi = PW[(p * 17 + 15 - ip) * 2 + 1], br = BB[(p * 16 + cp) * 2], bi = BB[(p * 16 + cp) * 2 + 1];
            v = (n < 64) ? (pr * br - pi * bi) : (pr * bi + pi * br); }
        Et[(size_t)n * 256 + kq] = (bf16_t)f2bf(v); }
    __syncthreads();
}

__device__ __forceinline__ void p0_prologue(Frame& F, const float* const* in) {
    unsigned char* ws = F.ws;
    if (F.bx < 64) ssm_precompute(F, in, F.bx);
    { const float* w_s = in[5]; bf16_t* wt = (bf16_t*)(ws + WS_WTRIL);
      for (int idx = F.bx * NTHR + F.tid; idx < 8 * 128 * 128; idx += F.G * NTHR) { const int t = (idx >> 7) & 127, s = idx & 127; wt[idx] = (s <= t) ? (bf16_t)f2bf(w_s[idx]) : (bf16_t)0; } }
    { const float* rw = in[20]; u32x4* rwf = (u32x4*)(ws + WS_RWF);
      for (int idx = F.bx * NTHR + F.tid; idx < 8 * 8 * 64; idx += F.G * NTHR) { const int ln = idx & 63, kk = (idx >> 6) & 7, wv = idx >> 9, e = ln & 15, q = ln >> 4;
          unsigned hi[8], lo[8];
#pragma unroll
          for (int j = 0; j < 8; ++j) { const float w = rw[(size_t)(256 * wv + 32 * kk + 8 * q + j) * 16 + e]; hi[j] = f2bf(w); lo[j] = f2bf(w - __uint_as_float(hi[j] << 16)); }
          rwf[((wv * 8 + kk) * 2) * 64 + ln] = (u32x4){hi[0] | (hi[1] << 16), hi[2] | (hi[3] << 16), hi[4] | (hi[5] << 16), hi[6] | (hi[7] << 16)};
          rwf[((wv * 8 + kk) * 2 + 1) * 64 + ln] = (u32x4){lo[0] | (lo[1] << 16), lo[2] | (lo[3] << 16), lo[4] | (lo[5] << 16), lo[6] | (lo[7] << 16)}; } }
    int itbase = 0;
    transpose_job_f8(F, in[1], ws + WS_WIN, 1, 2048, 4096, false, SC_AWI, itbase);
    transpose_job_f8(F, in[7], ws + WS_WOUT, 1, 2048, 2048, false, SC_AWO, itbase);
    transpose_job_f8(F, in[8], ws + WS_BWIN, 1, 2048, 1024, false, SC_BW, itbase);
    transpose_job_f8(F, in[17], ws + WS_BWOUT, 1, 1024, 4096, true, SC_BW, itbase);
    { const float* x = in[0]; bf16_t* xb = (bf16_t*)(ws + WS_A); unsigned char* x8 = ws + WS_X8;
      for (size_t i = (size_t)F.bx * NTHR + F.tid; i < (size_t)NTOK * D / 8; i += (size_t)F.G * NTHR) { const f32x4 a = *(const f32x4*)(x + i * 8), b = *(const f32x4*)(x + i * 8 + 4);
          u32x4 w; w.x = cvt_pk_bf16(a[0], a[1]); w.y = cvt_pk_bf16(a[2], a[3]); w.z = cvt_pk_bf16(b[0], b[1]); w.w = cvt_pk_bf16(b[2], b[3]); *(u32x4*)(xb + i * 8) = w;
          u32x2 w8; w8.x = pk4_fp8(a[0], a[1], a[2], a[3]); w8.y = pk4_fp8(b[0], b[1], b[2], b[3]); *(u32x2*)(x8 + i * 8) = w8; } }
}

__device__ __forceinline__ int fV(int d) { return (d & 3) | (((d >> 4) & 3) << 2); }
__device__ __forceinline__ void g2_phase(Frame& F, const float* const* in) {
    const unsigned char* UV = F.ws + WS_B; const bf16_t* WT = (const bf16_t*)(F.ws + WS_WTRIL); unsigned char* P8 = F.ws + WS_H8;
    const float* lng = in[3]; const float* lnb = in[4]; const float* b_s = in[6];
    LAS unsigned char* VT = F.lds;
    LAS unsigned char* WSM = F.lds + 65536;
    LAS float* ST = (LAS float*)(F.lds + 98304);
    const int tid = F.tid, lane = F.lane, wave = F.wave, fr = lane & 15, fq = lane >> 4;
    const int sblk = tid >> 5, dblk = tid & 31;
    for (int ch = F.bx; ch < NTOK / CHUNK; ch += F.G) {
        const int tok0 = ch * CHUNK;
        const unsigned char* cUV = UV + (size_t)tok0 * 4096; unsigned char* cP8 = P8 + (size_t)tok0 * D;
        __syncthreads();
#pragma unroll 1
        for (int hb = 0; hb < 2; ++hb) {
            u32x4 w[8][2];
            unsigned so = (unsigned)((wave * 16 + hb * 8) * 4096 + 2048 + lane * 16); asm volatile("" : "+v"(so));
#pragma unroll
            for (int rr = 0; rr < 8; ++rr) { w[rr][0] = *(const u32x4*)(cUV + (so + rr * 4096u)); w[rr][1] = *(const u32x4*)(cUV + (so + rr * 4096u + 1024u)); }
#pragma unroll
            for (int rr = 0; rr < 8; ++rr) { float s = 0.f, s2 = 0.f;
#pragma unroll
                for (int j = 0; j < 2; ++j)
#pragma unroll
                    for (int q = 0; q < 4; ++q) { float f[4]; unpk4_fp8(w[rr][j][q], f);
#pragma unroll
                        for (int e = 0; e < 4; ++e) { s += f[e]; s2 += f[e] * f[e]; } }
                s = wave_sum(s) * (1.0f / SC_UV); s2 = wave_sum(s2) * (1.0f / (SC_UV * SC_UV));
                const float mu = s * (1.0f / 2048.0f), var = s2 * (1.0f / 2048.0f) - mu * mu; const int r = wave * 16 + hb * 8 + rr;
                if (lane == 0) { ST[r * 2] = mu; ST[r * 2 + 1] = 1.0f / sqrtf(fmaxf(var, 0.f) + LN_EPS); } }
        }
        u32x4 wreg[4]; u32x2 vreg[8]; f32x4 gbr[4];
#define G2_LOAD(gg) do { _Pragma("unroll") for (int q = 0; q < 4; ++q) { const int idx = tid + 512 * q; wreg[q] = *(const u32x4*)(WT + ((size_t)(gg) * 128 + (idx >> 4)) * 128 + (idx & 15) * 8); } \
            const int dc_ = (gg) * 256 + dblk * 8; unsigned vo_ = (unsigned)(sblk * 8 * 4096 + 2048 + dc_); asm volatile("" : "+v"(vo_)); \
            _Pragma("unroll") for (int r = 0; r < 8; ++r) vreg[r] = *(const u32x2*)(cUV + (vo_ + r * 4096u)); \
            gbr[0] = *(const f32x4*)(lng + dc_); gbr[1] = *(const f32x4*)(lng + dc_ + 4); gbr[2] = *(const f32x4*)(lnb + dc_); gbr[3] = *(const f32x4*)(lnb + dc_ + 4); } while (0)
        G2_LOAD(0);
        __syncthreads();
#pragma unroll 1
        for (int g = 0; g < AG; ++g) {
#pragma unroll
            for (int q = 0; q < 4; ++q) { const int idx = tid + 512 * q, t = idx >> 4, c16 = idx & 15; *(LAS u32x4*)(WSM + t * 256 + ((c16 ^ (t & 15)) << 4)) = wreg[q]; }
            { unsigned pk[4][8];
#pragma unroll
              for (int rp = 0; rp < 4; ++rp) { const int s0 = sblk * 8 + 2 * rp; const f32x4 st = *(const LAS f32x4*)(ST + s0 * 2);
                  float f0[8], f1[8]; unpk4_fp8(vreg[2 * rp].x, f0); unpk4_fp8(vreg[2 * rp].y, f0 + 4); unpk4_fp8(vreg[2 * rp + 1].x, f1); unpk4_fp8(vreg[2 * rp + 1].y, f1 + 4);
#pragma unroll
                  for (int q = 0; q < 8; ++q) { const float gq = gbr[q >> 2][q & 3], bq = gbr[2 + (q >> 2)][q & 3];
                      pk[rp][q] = cvt_pk_bf16((f0[q] * (1.0f / SC_UV) - st[0]) * st[1] * gq + bq, (f1[q] * (1.0f / SC_UV) - st[2]) * st[3] * gq + bq); } }
#pragma unroll
              for (int j = 0; j < 8; ++j) { const int d = dblk * 8 + j; u32x4 w; w.x = pk[0][j]; w.y = pk[1][j]; w.z = pk[2][j]; w.w = pk[3][j];
                  *(LAS u32x4*)(VT + d * 256 + ((sblk ^ fV(d)) << 4)) = w; } }
            __syncthreads();
            if (g + 1 < AG) G2_LOAD(g + 1);
            const int wd = wave & 3, wt = wave >> 2;
            u32x4 ureg[4]; float bsr[4];
            unsigned uo = (unsigned)(fr * 4096 + g * 256 + wd * 64 + 16 * fq); asm volatile("" : "+v"(uo));
#pragma unroll
            for (int mi = 0; mi < 4; ++mi) { const int m = 2 * mi + (((mi & 1) ^ wt) ? 1 : 0); ureg[mi] = *(const u32x4*)(cUV + (uo + (unsigned)m * 65536u)); bsr[mi] = b_s[g * 128 + 16 * m + fr]; }
            f32x4 acc[4][4];
#pragma unroll
            for (int mi = 0; mi < 4; ++mi)
#pragma unroll
                for (int n = 0; n < 4; ++n) acc[mi][n] = (f32x4){0.f, 0.f, 0.f, 0.f};
#pragma unroll
            for (int ks = 0; ks < 4; ++ks) {
                bf16x8 bfr[4];
#pragma unroll
                for (int n = 0; n < 4; ++n) { const int d = wd * 64 + 16 * (fr >> 2) + 4 * n + (fr & 3); bfr[n] = *(const LAS bf16x8*)(VT + d * 256 + (((4 * ks + fq) ^ fV(d)) << 4)); }
#pragma unroll
                for (int mi = 0; mi < 4; ++mi) { const int m = 2 * mi + (((mi & 1) ^ wt) ? 1 : 0);
                    if (m >= 2 * ks) { const int t = 16 * m + fr; const bf16x8 afr = *(const LAS bf16x8*)(WSM + t * 256 + (((4 * ks + fq) ^ (t & 15)) << 4));
#pragma unroll
                        for (int n = 0; n < 4; ++n) acc[mi][n] = __builtin_amdgcn_mfma_f32_16x16x32_bf16(bfr[n], afr, acc[mi][n], 0, 0, 0); } }
            }
            unsigned po = (unsigned)(fr * D + g * 256 + wd * 64 + 16 * fq); asm volatile("" : "+v"(po));
#pragma unroll
            for (int mi = 0; mi < 4; ++mi) { const int m = 2 * mi + (((mi & 1) ^ wt) ? 1 : 0); const float bs = bsr[mi]; constexpr float SPU = SC_P / SC_UV; u32x4 w;
#pragma unroll
                for (int n = 0; n < 4; ++n) { float f[4]; unpk4_fp8(ureg[mi][n], f);
                    w[n] = pk4_fp8(SPU * f[0] * (acc[mi][n][0] + bs), SPU * f[1] * (acc[mi][n][1] + bs), SPU * f[2] * (acc[mi][n][2] + bs), SPU * f[3] * (acc[mi][n][3] + bs)); }
                *(u32x4*)(cP8 + (po + (unsigned)m * 16u * D)) = w; }
            __syncthreads();
        }
#undef G2_LOAD
    }
}

__device__ __forceinline__ void ln_route_phase(Frame& F, const float* const* in, int layer) {
    const bf16_t* Z = (const bf16_t*)(F.ws + WS_C); const bf16_t* RES = (const bf16_t*)(F.ws + WS_A); bf16_t* H = (bf16_t*)(F.ws + WS_D); unsigned char* H8 = F.ws + WS_H8;
    const float* lng = in[18] + layer * D; const float* lnb = in[19] + layer * D; const float* rw = in[20]; const float* rb = in[21];
    int* rowlist = (int*)(F.ws + WS_ROWLIST); i32x4* toki = (i32x4*)(F.ws + WS_TOKI); f32x2* tokg = (f32x2*)(F.ws + WS_TOKG);
    unsigned* gcnt = F.ctl + CW_CNT + 64 * layer;
    LAS unsigned char* T = F.lds;
    LAS float* PART = (LAS float*)(F.lds + 65792);
    LAS int* LCNT = (LAS int*)(F.lds + 65792 + 8192);
    LAS int* LBASE = LCNT + 16;
    LAS int* TE = LBASE + 16;
    LAS int* TR = TE + 512;
    const int tid = F.tid, lane = F.lane, wave = F.wave, fr = lane & 15, fq = lane >> 4;
    bf16x8 rwh[8], rwl[8];
    { const bf16x8* rwf = (const bf16x8*)(F.ws + WS_RWF) + (size_t)wave * 8 * 2 * 64 + lane;
#pragma unroll
      for (int kk = 0; kk < 8; ++kk) { rwh[kk] = rwf[(kk * 2) * 64]; rwl[kk] = rwf[(kk * 2 + 1) * 64]; } }
    LAS float* GB = (LAS float*)(F.lds + 81920);
    __syncthreads();
    for (int i = tid; i < D / 4; i += NTHR) { *(LAS f32x4*)(GB + 4 * i) = *(const f32x4*)(lng + 4 * i); *(LAS f32x4*)(GB + D + 4 * i) = *(const f32x4*)(lnb + 4 * i); }
    if (tid < 16) LCNT[tid] = 0;
    __syncthreads();
    int nloc = 0;
    for (int it = 0, grp = F.bx; grp < NTOK / 16; ++it, grp += F.G) {
#pragma unroll 1
        for (int rr = 0; rr < 2; ++rr) { const int r = 2 * wave + rr; const size_t tok = (size_t)grp * 16 + r; const bf16_t* zp = Z + tok * D; const bf16_t* rp = RES + tok * D;
            float x[4][8]; float s = 0.f;
#pragma unroll
            for (int j = 0; j < 4; ++j) { const u32x2 w = *(const u32x2*)((const unsigned char*)Z + tok * D + (j * 64 + lane) * 8); const u32x4 rv = *(const u32x4*)(rp + (j * 64 + lane) * 8);
                float f[8]; unpk4_fp8(w.x, f); unpk4_fp8(w.y, f + 4);
#pragma unroll
                for (int q = 0; q < 4; ++q) { x[j][2 * q] = ALPHA * bf_lo(rv[q]) + f[2 * q] * (1.0f / SC_Z); x[j][2 * q + 1] = ALPHA * bf_hi(rv[q]) + f[2 * q + 1] * (1.0f / SC_Z); s += x[j][2 * q] + x[j][2 * q + 1]; } }
            const float mu = wave_sum(s) * (1.0f / D); float s2 = 0.f;
#pragma unroll
            for (int j = 0; j < 4; ++j)
#pragma unroll
                for (int q = 0; q < 8; ++q) { x[j][q] -= mu; s2 += x[j][q] * x[j][q]; }
            const float rs = 1.0f / sqrtf(wave_sum(s2) * (1.0f / D) + LN_EPS);
#pragma unroll
            for (int j = 0; j < 4; ++j) { const int c0 = (j * 64 + lane) * 8;
                const f32x4 g0 = *(const LAS f32x4*)(GB + c0), g1 = *(const LAS f32x4*)(GB + c0 + 4), b0 = *(const LAS f32x4*)(GB + D + c0), b1 = *(const LAS f32x4*)(GB + D + c0 + 4);
                float o[8];
#pragma unroll
                for (int q = 0; q < 4; ++q) { o[q] = x[j][q] * rs * g0[q] + b0[q]; o[4 + q] = x[j][4 + q] * rs * g1[q] + b1[q]; }
                u32x4 w; w.x = cvt_pk_bf16(o[0], o[1]); w.y = cvt_pk_bf16(o[2], o[3]); w.z = cvt_pk_bf16(o[4], o[5]); w.w = cvt_pk_bf16(o[6], o[7]);
                *(u32x4*)(H + tok * D + c0) = w; *(LAS u32x4*)(T + r * 4112 + (j * 64 + lane) * 16) = w;
                u32x2 w8; w8.x = pk4_fp8(o[0], o[1], o[2], o[3]); w8.y = pk4_fp8(o[4], o[5], o[6], o[7]); *(u32x2*)(H8 + tok * D + c0) = w8; } }
        __syncthreads();
        { f32x4 acc = (f32x4){0.f, 0.f, 0.f, 0.f};
#pragma unroll
          for (int kk = 0; kk < 8; ++kk) { const bf16x8 a = *(const LAS bf16x8*)(T + fr * 4112 + (256 * wave + 32 * kk + 8 * fq) * 2);
              acc = __builtin_amdgcn_mfma_f32_16x16x32_bf16(a, rwh[kk], acc, 0, 0, 0); acc = __builtin_amdgcn_mfma_f32_16x16x32_bf16(a, rwl[kk], acc, 0, 0, 0); }
#pragma unroll
          for (int j = 0; j < 4; ++j) PART[(wave * 16 + 4 * fq + j) * 16 + fr] = acc[j]; }
        __syncthreads();
        if (tid < 16) {
            const int r = tid; const int tok = grp * 16 + r; float lg[16]; float mx = -3.0e38f;
#pragma unroll
            for (int e4 = 0; e4 < 4; ++e4) { const f32x4 b4 = *(const f32x4*)(rb + 4 * e4); lg[4 * e4] = b4[0]; lg[4 * e4 + 1] = b4[1]; lg[4 * e4 + 2] = b4[2]; lg[4 * e4 + 3] = b4[3]; }
#pragma unroll 1
            for (int w = 0; w < 8; ++w) {
#pragma unroll
                for (int e4 = 0; e4 < 4; ++e4) { const f32x4 p4 = *(const LAS f32x4*)(PART + (w * 16 + r) * 16 + 4 * e4); lg[4 * e4] += p4[0]; lg[4 * e4 + 1] += p4[1]; lg[4 * e4 + 2] += p4[2]; lg[4 * e4 + 3] += p4[3]; } }
#pragma unroll
            for (int e = 0; e < 16; ++e) mx = fmaxf(mx, lg[e]);
#pragma unroll
            for (int e = 0; e < 16; ++e) lg[e] = __expf(lg[e] - mx);
            int bg = 0; float bscore = -1.f;
#pragma unroll
            for (int gq = 0; gq < 4; ++gq) { float a = -1.f, b = -1.f;
#pragma unroll
                for (int q = 0; q < 4; ++q) { const float p = lg[4 * gq + q]; if (p > a) { b = a; a = p; } else if (p > b) b = p; }
                const float sc = a + b; if (sc > bscore) { bscore = sc; bg = gq; } }
            int i0 = 0, i1 = 0; float p0 = -1.f, p1 = -1.f;
#pragma unroll
            for (int gq = 0; gq < 4; ++gq) if (gq == bg) {
#pragma unroll
                for (int q = 0; q < 4; ++q) { const float p = lg[4 * gq + q]; if (p > p0) { p1 = p0; i1 = i0; p0 = p; i0 = 4 * gq + q; } else if (p > p1) { p1 = p; i1 = 4 * gq + q; } } }
            const float inv = 1.0f / (p0 + p1);
            tokg[tok] = (f32x2){p0 * inv, p1 * inv};
            const int lt = it * 16 + r;
            TE[lt * 2] = i0; TE[lt * 2 + 1] = i1;
            TR[lt * 2] = atomicAdd((int*)&LCNT[i0], 1); TR[lt * 2 + 1] = atomicAdd((int*)&LCNT[i1], 1);
        }
        nloc = it * 16 + 16;
    }
    __syncthreads();
    if (tid < 16) LBASE[tid] = (int)__hip_atomic_fetch_add(gcnt + tid, (unsigned)LCNT[tid], __ATOMIC_RELAXED, __HIP_MEMORY_SCOPE_AGENT);
    __syncthreads();
    for (int lt = tid; lt < nloc; lt += NTHR) { const int it = lt >> 4, r = lt & 15; const int tok = (F.bx + it * F.G) * 16 + r;
        const int e0 = TE[lt * 2], e1 = TE[lt * 2 + 1]; const int s0 = LBASE[e0] + TR[lt * 2], s1 = LBASE[e1] + TR[lt * 2 + 1];
        rowlist[e0 * NTOK + s0] = tok; rowlist[e1 * NTOK + s1] = tok;
        toki[tok] = (i32x4){e0 | (e1 << 8), s0, s1, 0}; }
    __syncthreads();
}

__device__ __forceinline__ MoeTab moe_tables(Frame& F, int layer) {
    LAS int* M = (LAS int*)(F.lds + LDS_MOE);
    __syncthreads();
    if (F.tid == 0) { int tp = 0, sb = 0;
        for (int e = 0; e < 16; ++e) { const int c = (int)__hip_atomic_load(F.ctl + CW_CNT + 64 * layer + e, __ATOMIC_RELAXED, __HIP_MEMORY_SCOPE_AGENT); const int tl = (c + 255) >> 8;
            M[e] = tp; M[32 + e] = sb; M[64 + e] = c; tp += tl; sb += tl * 256; }
        M[16] = tp; }
    __syncthreads();
    MoeTab T; T.tp = M; T.sb = M + 32; T.cnt = M + 64; T.nU = __builtin_amdgcn_readfirstlane(M[16]) * 8; return T;
}

template <bool FINAL>
__device__ __forceinline__ void ln2_phase(Frame& F, const float* const* in, int layer, const MoeTab& T, float* out) {
    const bf16_t* H = (const bf16_t*)(F.ws + WS_D); const unsigned char* YB = F.ws + WS_B; bf16_t* H2 = (bf16_t*)(F.ws + WS_A);
    const float* lng = in[24] + layer * D; const float* lnb = in[25] + layer * D;
    const i32x4* toki = (const i32x4*)(F.ws + WS_TOKI); const f32x2* tokg = (const f32x2*)(F.ws + WS_TOKG);
    const int lane = F.lane;
    float gm[4][8], bt[4][8];
#pragma unroll
    for (int j = 0; j < 4; ++j) { const int c0 = (j * 64 + lane) * 8; const f32x4 g0 = *(const f32x4*)(lng + c0), g1 = *(const f32x4*)(lng + c0 + 4), b0 = *(const f32x4*)(lnb + c0), b1 = *(const f32x4*)(lnb + c0 + 4);
#pragma unroll
        for (int q = 0; q < 4; ++q) { gm[j][q] = g0[q]; gm[j][4 + q] = g1[q]; bt[j][q] = b0[q]; bt[j][4 + q] = b1[q]; } }
    const int gw = F.bx * NWAVES + F.wave, NGW = F.G * NWAVES;
    for (int tok = gw; tok < NTOK; tok += NGW) {
        const i32x4 ti = toki[tok]; const f32x2 tg = tokg[tok];
        const int e0 = ti.x & 255, e1 = (ti.x >> 8) & 255; const size_t p0 = (size_t)(T.sb[e0] + ti.y), p1 = (size_t)(T.sb[e1] + ti.z);
        float x[4][8]; float s = 0.f;
#pragma unroll
        for (int j = 0; j < 4; ++j) { const int c0 = (j * 64 + lane) * 8; const u32x4 h = *(const u32x4*)(H + (size_t)tok * D + c0); const u32x2 y0 = *(const u32x2*)(YB + p0 * D + c0), y1 = *(const u32x2*)(YB + p1 * D + c0);
            float a0[8], a1[8]; unpk4_fp8(y0.x, a0); unpk4_fp8(y0.y, a0 + 4); unpk4_fp8(y1.x, a1); unpk4_fp8(y1.y, a1 + 4);
            const float g0 = tg.x * (1.0f / SC_Y), g1 = tg.y * (1.0f / SC_Y);
#pragma unroll
            for (int q = 0; q < 4; ++q) { x[j][2 * q] = ALPHA * bf_lo(h[q]) + g0 * a0[2 * q] + g1 * a1[2 * q]; x[j][2 * q + 1] = ALPHA * bf_hi(h[q]) + g0 * a0[2 * q + 1] + g1 * a1[2 * q + 1]; s += x[j][2 * q] + x[j][2 * q + 1]; } }
        const float mu = wave_sum(s) * (1.0f / D); float s2 = 0.f;
#pragma unroll
        for (int j = 0; j < 4; ++j)
#pragma unroll
            for (int q = 0; q < 8; ++q) { x[j][q] -= mu; s2 += x[j][q] * x[j][q]; }
        const float rs = 1.0f / sqrtf(wave_sum(s2) * (1.0f / D) + LN_EPS);
#pragma unroll
        for (int j = 0; j < 4; ++j) { const int c0 = (j * 64 + lane) * 8; float o[8];
#pragma unroll
            for (int q = 0; q < 8; ++q) o[q] = x[j][q] * rs * gm[j][q] + bt[j][q];
            if constexpr (FINAL) { *(f32x4*)(out + (size_t)tok * D + c0) = (f32x4){o[0], o[1], o[2], o[3]}; *(f32x4*)(out + (size_t)tok * D + c0 + 4) = (f32x4){o[4], o[5], o[6], o[7]}; }
            else { u32x4 w; w.x = cvt_pk_bf16(o[0], o[1]); w.y = cvt_pk_bf16(o[2], o[3]); w.z = cvt_pk_bf16(o[4], o[5]); w.w = cvt_pk_bf16(o[6], o[7]); *(u32x4*)(H2 + (size_t)tok * D + c0) = w;
                u32x2 w8; w8.x = pk4_fp8(o[0], o[1], o[2], o[3]); w8.y = pk4_fp8(o[4], o[5], o[6], o[7]); *(u32x2*)(F.ws + WS_H8 + (size_t)tok * D + c0) = w8; } }
    }
}

__device__ __forceinline__ void scan_phase(Frame& F, const float* const* in) {
    const float* a_re = in[9]; const float* a_im = in[10]; const float* log_dt = in[11];
    const float* Xend = (const float*)(F.ws + WS_XEND); bf16_t* A2 = (bf16_t*)(F.ws + WS_A2);
    for (int idx = F.bx * NTHR + F.tid; idx < BG * NBATCH * BST; idx += F.G * NTHR) {
        const int p = idx & 63, b = (idx >> 6) & 15, g = idx >> 10;
        const float dt = expf(log_dt[g]); const float zr = a_re[g * 64 + p] * dt * 16.0f, zi = a_im[g * 64 + p] * dt * 16.0f;
        const float mag = expf(zr); float sn, cs; sincosf(zi, &sn, &cs); const float ar = mag * cs, ai = mag * sn;
        float xr = 0.f, xi = 0.f; const size_t row0 = (size_t)g * 2048 + b * 128;
#pragma unroll 8
        for (int j = 0; j < 128; ++j) { const size_t row = row0 + j; const float er = Xend[row * 128 + p], ei = Xend[row * 128 + 64 + p];
            A2[row * 384 + 256 + p] = (bf16_t)f2bf(xr); A2[row * 384 + 320 + p] = (bf16_t)f2bf(xi);
            const float nr = ar * xr - ai * xi + er, ni = ar * xi + ai * xr + ei; xr = nr; xi = ni; }
    }
}

__device__ __forceinline__ void convert_experts(Frame& F, const float* const* in, int layer) {
    int itbase = 0; __syncthreads();
    transpose_job_f8(F, in[22] + (size_t)layer * 16 * 2048 * 2048, F.ws + (layer == 0 ? WS_EIN : WS_EIN1), 16, 2048, 2048, true, SC_WIN, itbase);
    transpose_job_f8(F, in[23] + (size_t)layer * 16 * 1024 * 2048, F.ws + (layer == 0 ? WS_EOUT : WS_EOUT1), 16, 1024, 2048, false, SC_WOUT, itbase);
    __syncthreads();
}
#ifndef PHASE_MASK
#define PHASE_MASK 0x1ffff
#endif
template <int LAYER>
__device__ __forceinline__ void moe_block(Frame& F, const Args& args, const XcdBarrier& bar) {
    const int lo = args.ph_lo, hi = args.ph_hi; const float* const* in = args.in; unsigned char* ws = args.ws;
    constexpr int pb = LAYER == 0 ? 4 : 13;
#define IN(k) (((PHASE_MASK >> (k)) & 1) && lo <= (k) && (k) < hi)
#define SEAM(k) do { if (IN(k) && IN((k) + 1)) xcd_barrier(bar); } while (0)
    if (IN(pb)) { ln_route_phase(F, in, LAYER); } SEAM(pb);
    if (IN(pb + 1)) { MoeTab T = moe_tables(F, LAYER);
        GemmM1 g; g.nostore = args.flags & 1; g.init_bytes(2048, 2048, F.G, F.bx); g.H8 = ws + WS_H8; g.Bt = ws + (LAYER == 0 ? WS_EIN : WS_EIN1); g.ACT = ws + WS_A; g.T = T;
        LAS int* rows = (LAS int*)(F.lds + LDS_ROWS); g.rows = rows;
        const int* rowlist = (const int*)(ws + WS_ROWLIST);
        { pg8::Unit u; for (int ui = 0; ui < 10 && g.next(ui, u); ++ui) { if (F.tid < 256) { const int slot = u.w * 256 + F.tid; rows[ui * 256 + F.tid] = (slot < __builtin_amdgcn_readfirstlane(T.cnt[u.z])) ? rowlist[u.z * NTOK + slot] : 0; } } }
        __syncthreads();
        if constexpr (LAYER == 0) { if (F.bx & 1) convert_experts(F, in, 1); }
        pg8::gemm_phase(F.lds, g);
        if constexpr (LAYER == 0) { if (!(F.bx & 1)) convert_experts(F, in, 1); } } SEAM(pb + 1);
    if (IN(pb + 2)) { MoeTab T = moe_tables(F, LAYER);
        GemmM2 g; g.nostore = args.flags & 1; g.init_bytes(1024, 1024, F.G, F.bx); g.ACT = ws + WS_A; g.Bt = ws + (LAYER == 0 ? WS_EOUT : WS_EOUT1); g.YB = ws + WS_B; g.T = T; g.hstepB = (size_t)8 * g.ldb2;
        pg8::gemm_phase(F.lds, g); } SEAM(pb + 2);
    if (IN(pb + 3)) { MoeTab T = moe_tables(F, LAYER);
        if constexpr (LAYER == 0) { ln2_phase<false>(F, in, 0, T, nullptr); }
        else ln2_phase<true>(F, in, 1, T, args.out); }
#undef IN
#undef SEAM
}

constexpr int N_PHASES = 17;
__global__ void __launch_bounds__(NTHR, 2) fwd_kernel(Args args) {
    extern __shared__ __attribute__((aligned(16))) unsigned char lds_raw[];
    Frame F; F.lds = (LAS unsigned char*)lds_raw; F.ws = args.ws; F.ctl = (unsigned*)(args.ws + WS_CTL);
    F.tid = threadIdx.x; F.lane = F.tid & 63; F.wave = __builtin_amdgcn_readfirstlane(F.tid >> 6); F.G = gridDim.x; F.bx = blockIdx.x;
    if (F.tid < 4) ((LAS unsigned*)(F.lds + LDS_BARW))[F.tid] = 0u;
    __syncthreads();
    XcdBarrier bar; bar.bar = F.ctl + CW_BAR; bar.x = 0; bar.st = nullptr;
    const bool one = (args.ph_hi - args.ph_lo) > 1;
    if (one) bar = xcd_barrier_post(F.ctl + CW_BAR, (volatile LAS unsigned*)(F.lds + LDS_BARW));
    const int lo = args.ph_lo, hi = args.ph_hi;
#ifndef PHASE_MASK
#define PHASE_MASK 0x1ffff
#endif
#define IN(k) (((PHASE_MASK >> (k)) & 1) && lo <= (k) && (k) < hi)
#define SEAM(k) do { if (IN(k) && IN((k) + 1)) xcd_barrier(bar); } while (0)
    const float* const* in = args.in;
    unsigned char* ws = args.ws;

    if (IN(0)) { p0_prologue(F, in); } SEAM(0);
    if (IN(1)) { GemmG1 g; g.nostore = args.flags & 1; g.init_bytes(2048, 2048, F.G, F.bx); g.A = ws + WS_X8; g.Bt = ws + WS_WIN; g.O = ws + WS_B; g.bias = in[2]; g.hstepB = (size_t)8 * g.ldb2;
        if (F.bx & 1) convert_experts(F, in, 0);
        pg8::gemm_phase(F.lds, g);
        if (!(F.bx & 1)) convert_experts(F, in, 0); } SEAM(1);
    if (IN(2)) { g2_phase(F, in); } SEAM(2);
    if (IN(3)) { GemmG3 g; g.nostore = args.flags & 1; g.init_bytes(2048, 2048, F.G, F.bx); g.A = ws + WS_H8; g.Bt = ws + WS_WOUT; g.Z = (bf16_t*)(ws + WS_C); g.R = (const bf16_t*)(ws + WS_A); g.hstepB = (size_t)8 * g.ldb2;
        pg8::gemm_phase(F.lds, g); } SEAM(3);
    moe_block<0>(F, args, bar);
    SEAM(7);
    if (IN(8)) { GemmS1 g; g.nostore = args.flags & 1; g.init_bytes(2048, 2048, F.G, F.bx); g.A = ws + WS_H8; g.Bt = ws + WS_BWIN; g.A2 = (bf16_t*)(ws + WS_A2); g.hstepB = (size_t)8 * g.ldb2;
        pg8::gemm_phase(F.lds, g); } SEAM(8);
    if (IN(9)) { GemmS2 g; g.nostore = args.flags & 1; g.init_plain(256, 384, F.G, F.bx); g.A2 = (const bf16_t*)(ws + WS_A2); g.Et = (const bf16_t*)(ws + WS_SSME); g.Xend = (float*)(ws + WS_XEND);
        pg8::gemm_phase(F.lds, g); } SEAM(9);
    if (IN(10)) { scan_phase(F, in); } SEAM(10);
    if (IN(11)) { GemmS4 g; g.nostore = args.flags & 1; g.init_plain(384, 384, F.G, F.bx); g.A2 = (const bf16_t*)(ws + WS_A2); g.Bs = (const bf16_t*)(ws + WS_SSMB); g.Y = ws + WS_Y; g.hstepB = (size_t)8 * g.ldb2;
        pg8::gemm_phase(F.lds, g); } SEAM(11);
    if (IN(12)) { GemmS5 g; g.nostore = args.flags & 1; g.init_bytes(1024, 0, F.G, F.bx); g.kstepA = 8u * 2048u * 256u; g.Y = ws + WS_Y; g.Bt = ws + WS_BWOUT; g.Z = (bf16_t*)(ws + WS_C); g.R = (const bf16_t*)(ws + WS_A);
        pg8::gemm_phase(F.lds, g); } SEAM(12);
    moe_block<1>(F, args, bar);
#undef IN
#undef SEAM
}

extern "C" void kernel_launch(void* const* d_in, const int* in_sizes, int n_in, void* d_out, int out_size, void* d_ws, size_t ws_size, hipStream_t stream) {
    static int grid = 0;
    if (grid == 0) {
        if (n_in != 26 || in_sizes[0] != NTOK * D || out_size != NTOK * D || ws_size < WS_END) { fprintf(stderr, "kernel_launch: unexpected problem (n_in %d, ws %zu)\n", n_in, ws_size); grid = -1; return; }
        int dev = 0, cus = 0, per_cu = 0;
        if (hipGetDevice(&dev) != hipSuccess || hipDeviceGetAttribute(&cus, hipDeviceAttributeMultiprocessorCount, dev) != hipSuccess) { grid = -1; return; }
        if (hipFuncSetAttribute((const void*)fwd_kernel, hipFuncAttributeMaxDynamicSharedMemorySize, LDS_BYTES) != hipSuccess) { fprintf(stderr, "kernel_launch: hipFuncSetAttribute failed\n"); grid = -1; return; }
        if (hipOccupancyMaxActiveBlocksPerMultiprocessor(&per_cu, (const void*)fwd_kernel, NTHR, LDS_BYTES) != hipSuccess || per_cu < 1) fprintf(stderr, "kernel_launch: occupancy query reports %d\n", per_cu);
        (void)hipGetLastError();
        grid = cus;
        if (grid != 256) fprintf(stderr, "kernel_launch: %d CUs (built for 256)\n", grid);
    }
    if (grid < 0) return;
    if (hipMemsetAsync((char*)d_ws + WS_CTL, 0, CTL_ZERO_BYTES, stream) != hipSuccess) return;
    Args a{};
    for (int i = 0; i < 26; ++i) a.in[i] = (const float*)d_in[i];
    a.out = (float*)d_out; a.ws = (unsigned char*)d_ws;
#if MK_N_LAUNCHES == 1
    a.ph_lo = 0; a.ph_hi = N_PHASES;
    hipLaunchKernelGGL(fwd_kernel, dim3(grid), dim3(NTHR), LDS_BYTES, stream, a);
#else
    for (int p = 0; p < N_PHASES; ++p) { a.ph_lo = p; a.ph_hi = p + 1; for (int r = 0; r < 1 + ((REPEAT_MASK >> p) & 1); ++r) { a.flags = (PROBE_NOSTORE && r == 0 && ((REPEAT_MASK >> p) & 1)) ? 1 : 0; hipLaunchKernelGGL(fwd_kernel, dim3(grid), dim3(NTHR), LDS_BYTES, stream, a); } }
#endif
}
```

```cpp
#include <hip/hip_runtime.h>
#include <cstdio>
#include <cstdint>

#ifndef PROBE_NOSTORE
#define PROBE_NOSTORE 0
#endif
#ifndef REPEAT_MASK
#define REPEAT_MASK 0x0
#endif
#ifndef MK_N_LAUNCHES
#define MK_N_LAUNCHES 1
#endif

#define GAS __attribute__((address_space(1)))
#define LAS __attribute__((address_space(3)))
typedef unsigned short bf16_t;
typedef short bf16x8 __attribute__((ext_vector_type(8)));
typedef float f32x4 __attribute__((ext_vector_type(4)));
typedef float f32x2 __attribute__((ext_vector_type(2)));
typedef unsigned u32x4 __attribute__((ext_vector_type(4)));
typedef unsigned u32x2 __attribute__((ext_vector_type(2)));
typedef int i32x4 __attribute__((ext_vector_type(4)));
typedef int i32x8 __attribute__((ext_vector_type(8)));

constexpr int D = 2048, NTOK = 32768, SEQ = 2048, NBATCH = 16;
constexpr int CHUNK = 128, AG = 8, AGD = 256;
constexpr int BW = 1024, BG = 64, BCH = 16, BST = 64;
constexpr int NE = 16, DFF = 1024;
constexpr float ALPHA = 1.41421356237f, LN_EPS = 1e-5f;
constexpr int NWAVES = 8, NTHR = 512;

constexpr size_t MiB = 1u << 20;
constexpr size_t WS_CTL = 0, CTL_ZERO_BYTES = 1 * MiB;
constexpr size_t WS_ROWLIST = 1 * MiB;
constexpr size_t WS_TOKI = 3 * MiB;
constexpr size_t WS_TOKG = 3 * MiB + 512 * 1024;
constexpr size_t WS_WTRIL = 3 * MiB + 768 * 1024;
constexpr size_t WS_SSMB = 4 * MiB;
constexpr size_t WS_SSME = 16 * MiB;
constexpr size_t WS_RWF = 24 * MiB;
constexpr size_t WS_WIN = 32 * MiB;
constexpr size_t WS_WOUT = 48 * MiB;
constexpr size_t WS_BWIN = 56 * MiB;
constexpr size_t WS_BWOUT = 60 * MiB;
constexpr size_t WS_EIN = 72 * MiB;
constexpr size_t WS_H8 = 136 * MiB;
constexpr size_t WS_EOUT = 200 * MiB;
constexpr size_t WS_A = 264 * MiB;
constexpr size_t WS_B = 408 * MiB;
constexpr size_t WS_C = 664 * MiB;
constexpr size_t WS_D = 792 * MiB;
constexpr size_t WS_EIN1 = 920 * MiB;
constexpr size_t WS_EOUT1 = 984 * MiB;
constexpr size_t WS_END = 1016 * MiB;
constexpr size_t WS_X8 = WS_D;
constexpr size_t WS_A2 = WS_B, WS_XEND = WS_B + 96 * MiB, WS_Y = WS_B + 160 * MiB;
constexpr int ACT_ROWS = 65536 + 16 * 256;
constexpr int CW_BAR = 4096;
constexpr int CW_XQ = 16384 + 1024;
constexpr int CW_CNT = 16384;

constexpr int RING_BYTES = 131072;
constexpr int LDS_ROWS = RING_BYTES;
constexpr int LDS_MOE = LDS_ROWS + 10 * 1024;
constexpr int LDS_BARW = LDS_MOE + 512;
constexpr int LDS_BYTES = 147456;

__device__ __forceinline__ unsigned cvt_pk_bf16(float lo, float hi) { unsigned r; asm("v_cvt_pk_bf16_f32 %0, %1, %2" : "=v"(r) : "v"(lo), "v"(hi)); return r; }
__device__ __forceinline__ float bf_lo(unsigned w) { return __uint_as_float(w << 16); }
__device__ __forceinline__ float bf_hi(unsigned w) { return __uint_as_float(w & 0xffff0000u); }
__device__ __forceinline__ unsigned f2bf(float f) { unsigned u = __float_as_uint(f); return (u + 0x7fffu + ((u >> 16) & 1u)) >> 16; }
__device__ __forceinline__ float wave_sum(float v) {
#pragma unroll
    for (int o = 1; o < 64; o <<= 1) v += __shfl_xor(v, o);
    return v;
}
__device__ __forceinline__ f32x2 gelu2(f32x2 x) {
    f32x2 xc; xc.x = __builtin_amdgcn_fmed3f(x.x, -3.5f, 3.5f); xc.y = __builtin_amdgcn_fmed3f(x.y, -3.5f, 3.5f);
    const f32x2 u = xc * xc;
    f32x2 p = u * (-8.701348406248144e-07f) + 4.0298804378835484e-05f; p = p * u + (-0.0007917149341665208f); p = p * u + 0.00885754730552435f; p = p * u + (-0.06504099816083908f); p = p * u + 0.3982582986354828f;
    return x * (xc * p + 0.5f);
}
__device__ __forceinline__ f32x2 gelu2x8(f32x2 x) {
    f32x2 xc; xc.x = __builtin_amdgcn_fmed3f(x.x, -3.5f, 3.5f); xc.y = __builtin_amdgcn_fmed3f(x.y, -3.5f, 3.5f);
    const f32x2 u = xc * xc;
    f32x2 p = u * (8.0f * -8.701348406248144e-07f) + (8.0f * 4.0298804378835484e-05f); p = p * u + (8.0f * -0.0007917149341665208f); p = p * u + (8.0f * 0.00885754730552435f); p = p * u + (8.0f * -0.06504099816083908f); p = p * u + (8.0f * 0.3982582986354828f);
    return x * (xc * p + 4.0f);
}
__device__ __forceinline__ f32x2 sig2(f32x2 g) {
    f32x2 gc; gc.x = __builtin_amdgcn_fmed3f(g.x, -7.0f, 7.0f); gc.y = __builtin_amdgcn_fmed3f(g.y, -7.0f, 7.0f);
    const f32x2 u = gc * gc;
    f32x2 p = u * 9.362564196147005e-11f + (-1.7167415933272423e-08f); p = p * u + 1.283512915506435e-06f; p = p * u + (-5.098102701595053e-05f); p = p * u + 0.0011952189961448312f; p = p * u + (-0.01824037730693817f); p = p * u + 0.247629314661026f;
    return gc * p + 0.5f;
}
__device__ __forceinline__ unsigned pk2(f32x2 v) { return cvt_pk_bf16(v.x, v.y); }
__device__ __forceinline__ unsigned pk4_fp8(float a, float b, float c, float d) {
    int w = 0;
    w = __builtin_amdgcn_cvt_pk_fp8_f32(__builtin_amdgcn_fmed3f(a, -448.f, 448.f), __builtin_amdgcn_fmed3f(b, -448.f, 448.f), w, false);
    w = __builtin_amdgcn_cvt_pk_fp8_f32(__builtin_amdgcn_fmed3f(c, -448.f, 448.f), __builtin_amdgcn_fmed3f(d, -448.f, 448.f), w, true);
    return (unsigned)w;
}
__device__ __forceinline__ void unpk4_fp8(unsigned w, float* o) { const f32x2 a = __builtin_amdgcn_cvt_pk_f32_fp8((int)w, false), b = __builtin_amdgcn_cvt_pk_f32_fp8((int)w, true); o[0] = a.x; o[1] = a.y; o[2] = b.x; o[3] = b.y; }
__device__ __forceinline__ unsigned pk4_fp8_nc(float a, float b, float c, float d) { int w = 0; w = __builtin_amdgcn_cvt_pk_fp8_f32(a, b, w, false); w = __builtin_amdgcn_cvt_pk_fp8_f32(c, d, w, true); return (unsigned)w; }
constexpr float SC_WIN = 32.0f, SC_WOUT = 64.0f, SC_ACT = 8.0f, SC_Y = 16.0f, SC_BW = 32.0f, SC_YS = 8.0f, SC_AWO = 64.0f, SC_P = 4.0f, SC_AWI = 32.0f, SC_UV = 8.0f, SC_Z = 16.0f;
#define LO2(v) ((f32x2){(v)[0], (v)[1]})
#define HI2(v) ((f32x2){(v)[2], (v)[3]})

#define XB_TMO      128
#define XB_XCNT(j)  (256  + 64 * (j))
#define XB_XSUB(j)  (1280 + 64 * (j))
#define XB_XGEN(j)  (2304 + 64 * (j))
#define XB_TOP      3328
#define XB_TOPGEN   3392
#define XCD_BAR_WORDS 3456
#define XB_SPIN_CAP (1u << 18)
__device__ __forceinline__ unsigned xb_ld(unsigned* p)              { return __hip_atomic_load(p, __ATOMIC_RELAXED, __HIP_MEMORY_SCOPE_AGENT); }
__device__ __forceinline__ unsigned xb_add(unsigned* p, unsigned v) { return __hip_atomic_fetch_add(p, v, __ATOMIC_RELAXED, __HIP_MEMORY_SCOPE_AGENT); }
__device__ __forceinline__ unsigned xb_xcc_id() { return (unsigned)__builtin_amdgcn_s_getreg((3 << 11) | 20) & 0xFu; }
#define XB_SPIN(cond, bar) do { unsigned _sp = 0; while (cond) { __builtin_amdgcn_s_sleep(1); \
    if ((++_sp & 255u) == 0u) { if (xb_ld(&(bar)[XB_TMO])) break; if (_sp > XB_SPIN_CAP) { atomicAdd(&(bar)[XB_TMO], 1u); break; } } } } while (0)
struct XcdBarrier { unsigned* bar; unsigned x; volatile LAS unsigned* st; };
__device__ __forceinline__ XcdBarrier xcd_barrier_post(unsigned* bar, volatile LAS unsigned* st) {
    XcdBarrier b; b.bar = bar; b.x = xb_xcc_id(); b.st = st;
    if (threadIdx.x == 0) (void)xb_add(&bar[XB_XCNT(b.x)], 1u);
    return b;
}
__device__ __forceinline__ void xcd_barrier_complete(unsigned* bar, unsigned x, unsigned& nloc, unsigned& nx) {
    const unsigned G = gridDim.x * gridDim.y * gridDim.z;
    unsigned sum, cnt, mine, sp = 0u;
    for (;;) {
        sum = 0u; cnt = 0u; mine = 0u;
#pragma unroll
        for (unsigned j = 0; j < 16; ++j) { const unsigned c = xb_ld(&bar[XB_XCNT(j)]); sum += c; cnt += (c > 0u) ? 1u : 0u; mine = (j == x) ? c : mine; }
        if (sum == G) break;
        __builtin_amdgcn_s_sleep(1);
        if ((++sp & 255u) == 0u) { if (xb_ld(&bar[XB_TMO])) break; if (sp > XB_SPIN_CAP) { atomicAdd(&bar[XB_TMO], 1u); break; } }
    }
    nloc = mine > 0u ? mine : 1u; nx = cnt > 0u ? cnt : 1u;
}
__device__ __forceinline__ void xcd_barrier(const XcdBarrier& b) {
    asm volatile("s_waitcnt vmcnt(0)" ::: "memory");
    __syncthreads();
    if (threadIdx.x == 0) {
        unsigned* bar = b.bar;
        __builtin_amdgcn_s_waitcnt(0);
        unsigned nloc = b.st[0], nx = b.st[1];
        if (nloc == 0u) { xcd_barrier_complete(bar, b.x, nloc, nx); b.st[0] = nloc; b.st[1] = nx; }
        const unsigned old = xb_add(&bar[XB_XSUB(b.x)], 1u);
        const unsigned gen = old / nloc;
        if (old + 1u == (gen + 1u) * nloc) {
            __builtin_amdgcn_fence(__ATOMIC_RELEASE, "agent");
            asm volatile("s_waitcnt vmcnt(0)" ::: "memory");
            const unsigned og = xb_add(&bar[XB_TOP], 1u);
            const unsigned tg = og / nx;
            if (og + 1u == (tg + 1u) * nx) xb_add(&bar[XB_TOPGEN], 1u);
            else XB_SPIN(xb_ld(&bar[XB_TOPGEN]) == tg, bar);
            __builtin_amdgcn_fence(__ATOMIC_ACQUIRE, "agent");
            xb_add(&bar[XB_XGEN(b.x)], 1u);
            asm volatile("s_waitcnt vmcnt(0)" ::: "memory");
        } else {
            XB_SPIN(xb_ld(&bar[XB_XGEN(b.x)]) == gen, bar);
            __builtin_amdgcn_fence(__ATOMIC_ACQUIRE, "agent");
            asm volatile("s_waitcnt vmcnt(0)" ::: "memory");
        }
    }
    __syncthreads();
}

namespace pg8 {
constexpr int BM = 256, BK = 64, HALF = 128, HTB = HALF * BK * 2, STAGE_BYTES = 8 * HTB, NXCD = 8, WGM = 8;
__device__ __forceinline__ int lds_byte(int r, int c) { const int st = (r >> 4) * 2 + (c >> 5), rr = r & 15, cc = c & 31, ob = rr * 64 + cc * 2; return st * 1024 + (ob ^ (((ob >> 9) & 1) << 5)); }
__device__ __forceinline__ void stage_rc(int b, int& R, int& C) { const int st = b / 1024, sb = b % 1024, swz = sb ^ (((sb >> 9) & 1) << 5); R = (st >> 1) * 16 + swz / 64; C = (st & 1) * 32 + (swz % 64) / 2; }
__device__ __forceinline__ int perm32(int rho) { const int n = rho >> 4, i = rho & 15; return 8 * (i >> 2) + 4 * n + (i & 3); }

struct Unit { const char* a; const char* b; int x, y, z, w; };
typedef f32x4 Acc[2][2][4][2];

__device__ __forceinline__ bool static_unit(long L, int nM, int nN, int& pm, int& pn) {
    const int nwg = nM * nN; if (L >= nwg) return false;
    int wgid = (int)L; { const int q = nwg / NXCD, r = nwg % NXCD, xcd = wgid % NXCD, off = wgid / NXCD; wgid = (xcd < r ? xcd * (q + 1) : r * (q + 1) + (xcd - r) * q) + off; }
    const int nig = WGM * nN, gid = wgid / nig, fm = gid * WGM, gsz = (nM - fm) < WGM ? (nM - fm) : WGM;
    pm = fm + ((wgid % nig) % gsz); pn = (wgid % nig) / gsz; return true;
}

template <class G>
__device__ __forceinline__ void gemm_phase(LAS unsigned char* lds, const G& g) {
    const int tid = threadIdx.x, wid = __builtin_amdgcn_readfirstlane(tid >> 6), lane = tid & 63, wr = wid >> 2, wc = wid & 3, fr = lane & 15, fq = lane >> 4;
    const int nt = g.nt;
    unsigned voffB[2], vA0[2], vA1[2], nA0[2], nA1[2]; int Rl[2], Cl[2];
#pragma unroll
    for (int i = 0; i < 2; ++i) { int R, C; stage_rc(tid * 16 + i * 8192, R, C); const int Rb = (G::PERMK == 2) ? (64 * (R >> 5) + 16 * ((R & 15) >> 2) + 4 * ((R >> 4) & 1) + (R & 3)) : (G::PERMK == 1) ? ((R & ~31) + perm32(R & 31)) : R;
        Rl[i] = R; Cl[i] = C; voffB[i] = g.voffB(Rb, C); }
    const size_t kstepA = g.kstepA, kstepB = g.kstepB, hstepB = g.hstepB;
    const unsigned ldsw = (unsigned)wid * 1024u;
    const int aoff = lds_byte(wr * 64 + fr, fq * 8), boff = lds_byte(wc * 32 + fr, fq * 8);
#define PG8_SA(b, h) (((b) * 2 + (h)) * HTB)
#define PG8_SB(b, h) ((4 + (b) * 2 + (h)) * HTB)
#define PG8_STAGE(bufoff, gbase, voff) do { _Pragma("unroll") for (int _i = 0; _i < 2; ++_i) \
        __builtin_amdgcn_global_load_lds((const unsigned*)((const char*)(gbase) + (voff)[_i]), (LAS unsigned*)(lds + (bufoff) + ldsw + _i * 8192), 16, 0, 0); } while (0)
#define PG8_LDA(dst, b, h) do { _Pragma("unroll") for (int m = 0; m < 4; ++m) _Pragma("unroll") for (int k = 0; k < 2; ++k) dst[m][k] = *(const LAS i32x4*)(lds + PG8_SA(b, h) + aoff + m * 2048 + k * 1024); } while (0)
#define PG8_LDB(dst, b, h) do { _Pragma("unroll") for (int n = 0; n < 2; ++n) _Pragma("unroll") for (int k = 0; k < 2; ++k) dst[n][k] = *(const LAS i32x4*)(lds + PG8_SB(b, h) + boff + n * 2048 + k * 1024); } while (0)
#define PG8_CAT(f) __builtin_shufflevector((f)[0], (f)[1], 0, 1, 2, 3, 4, 5, 6, 7)
#define PG8_MMA(ai, bj, At, Bt) do { __builtin_amdgcn_s_setprio(1); \
        if constexpr (G::FP8) { _Pragma("unroll") for (int m = 0; m < 4; ++m) _Pragma("unroll") for (int n = 0; n < 2; ++n) \
            asm volatile("v_mfma_scale_f32_16x16x128_f8f6f4 %0, %1, %2, %0, %3, %3 op_sel_hi:[0,0,0]" : "+v"(acc[ai][bj][m][n]) : "v"(PG8_CAT(Bt[n])), "v"(PG8_CAT(At[m])), "v"(sc1)); } \
        else { _Pragma("unroll") for (int m = 0; m < 4; ++m) _Pragma("unroll") for (int n = 0; n < 2; ++n) _Pragma("unroll") for (int k = 0; k < 2; ++k) \
            acc[ai][bj][m][n] = __builtin_amdgcn_mfma_f32_16x16x32_bf16(__builtin_bit_cast(bf16x8, Bt[n][k]), __builtin_bit_cast(bf16x8, At[m][k]), acc[ai][bj][m][n], 0, 0, 0); } \
        __builtin_amdgcn_s_setprio(0); } while (0)
#define PG8_WAIT_V(n) asm volatile("s_waitcnt vmcnt(" #n ")" ::: "memory")
#define PG8_WAIT_L(n) asm volatile("s_waitcnt lgkmcnt(" #n ")" ::: "memory")
#define PG8_BAR __builtin_amdgcn_s_barrier()
#define PG8_SCHED __builtin_amdgcn_sched_barrier(0)
    Unit cur, nxt; int ui = 0;
    if (!g.next(0, cur)) return;
    Acc acc;
#pragma unroll
    for (int a = 0; a < 2; ++a)
#pragma unroll
        for (int b = 0; b < 2; ++b)
#pragma unroll
            for (int m = 0; m < 4; ++m)
#pragma unroll
                for (int n = 0; n < 2; ++n) acc[a][b][m][n] = (f32x4){0.f, 0.f, 0.f, 0.f};
    i32x4 At[4][2], B0[2][2], B1[2][2];
    const int sc1 = 0x7f7f7f7f;
    const char* cA = cur.a; const char* cB = cur.b;
#pragma unroll
    for (int i = 0; i < 2; ++i) {
        if constexpr (G::GATHER) { vA0[i] = g.gatherA(0, Rl[i], Cl[i], 0); vA1[i] = g.gatherA(0, Rl[i], Cl[i], 1); }
        else { vA0[i] = g.voffA(Rl[i], Cl[i], 0); vA1[i] = g.voffA(Rl[i], Cl[i], 1); }
        nA0[i] = vA0[i]; nA1[i] = vA1[i];
    }
    PG8_STAGE(PG8_SB(0, 0), cB, voffB); PG8_STAGE(PG8_SB(0, 1), cB + hstepB, voffB); PG8_STAGE(PG8_SA(0, 0), cA, vA0); PG8_STAGE(PG8_SA(0, 1), cA, vA1);
    if (wr == 1) PG8_BAR;
    PG8_WAIT_V(2); PG8_BAR;
    PG8_STAGE(PG8_SB(1, 0), cB + kstepB, voffB); PG8_STAGE(PG8_SA(1, 0), cA + kstepA, vA0); PG8_STAGE(PG8_SB(1, 1), cB + hstepB + kstepB, voffB);
    PG8_WAIT_V(6); PG8_BAR;
    for (;;) {
        const bool has_next = g.next(ui + 1, nxt);
        const char* nA = has_next ? nxt.a : cA; const char* nB = has_next ? nxt.b : cB;
        for (int t = 0; t < nt; t += 2) {
            const bool last = (t == nt - 2);
            const char* a1 = cA + (size_t)(t + 1) * kstepA;
            const char* a2 = last ? nA : cA + (size_t)(t + 2) * kstepA; const char* b2 = last ? nB : cB + (size_t)(t + 2) * kstepB;
            const char* a3 = a2 + kstepA; const char* b3 = b2 + kstepB;
            unsigned s0[2], s1[2];
            if constexpr (G::GATHER) {
                if (last && has_next) {
#pragma unroll
                    for (int i = 0; i < 2; ++i) { nA0[i] = g.gatherA(ui + 1, Rl[i], Cl[i], 0); nA1[i] = g.gatherA(ui + 1, Rl[i], Cl[i], 1); }
                }
#pragma unroll
                for (int i = 0; i < 2; ++i) { s0[i] = last ? nA0[i] : vA0[i]; s1[i] = last ? nA1[i] : vA1[i]; }
            } else {
#pragma unroll
                for (int i = 0; i < 2; ++i) { s0[i] = vA0[i]; s1[i] = vA1[i]; }
            }
            PG8_LDB(B0, 0, 0); PG8_LDB(B1, 0, 1); PG8_SCHED; PG8_LDA(At, 0, 0); PG8_STAGE(PG8_SA(1, 1), a1, vA1);
            PG8_WAIT_V(8); PG8_WAIT_L(0); PG8_BAR; PG8_MMA(0, 0, At, B0); PG8_MMA(0, 1, At, B1); PG8_BAR; PG8_SCHED;
            PG8_LDA(At, 0, 1); PG8_STAGE(PG8_SB(0, 0), b2, voffB); PG8_STAGE(PG8_SB(0, 1), b2 + hstepB, voffB); PG8_STAGE(PG8_SA(0, 0), a2, s0);
            PG8_WAIT_V(8); PG8_WAIT_L(0); PG8_BAR; PG8_MMA(1, 0, At, B0); PG8_MMA(1, 1, At, B1); PG8_BAR; PG8_SCHED;
            PG8_LDB(B0, 1, 0); PG8_LDB(B1, 1, 1); PG8_SCHED; PG8_LDA(At, 1, 0); PG8_STAGE(PG8_SA(0, 1), a2, s1);
            PG8_WAIT_V(8); PG8_WAIT_L(0); PG8_BAR; PG8_MMA(0, 0, At, B0); PG8_MMA(0, 1, At, B1); PG8_BAR; PG8_SCHED;
            PG8_LDA(At, 1, 1); PG8_STAGE(PG8_SB(1, 0), b3, voffB); PG8_STAGE(PG8_SB(1, 1), b3 + hstepB, voffB); PG8_STAGE(PG8_SA(1, 0), a3, s0);
            PG8_WAIT_V(8); PG8_WAIT_L(0); PG8_BAR; PG8_MMA(1, 0, At, B0); PG8_MMA(1, 1, At, B1); PG8_BAR; PG8_SCHED;
        }
        if (wr == 0) PG8_BAR;
        if constexpr (G::FP8) asm volatile("s_nop 15\n\ts_nop 15\n\ts_nop 15" ::: "memory");
        if (!g.nostore) g.epi(acc, cur, wr, wc, fr, fq);
        if (!has_next) break;
#pragma unroll
        for (int a = 0; a < 2; ++a)
#pragma unroll
            for (int b = 0; b < 2; ++b)
#pragma unroll
                for (int m = 0; m < 4; ++m)
#pragma unroll
                    for (int n = 0; n < 2; ++n) acc[a][b][m][n] = (f32x4){0.f, 0.f, 0.f, 0.f};
        cur = nxt; cA = nA; cB = nB; ++ui;
#pragma unroll
        for (int i = 0; i < 2; ++i) { vA0[i] = nA0[i]; vA1[i] = nA1[i]; }
        if (wr == 1) PG8_BAR;
    }
    PG8_WAIT_V(0);
    PG8_BAR;
#undef PG8_SA
#undef PG8_SB
#undef PG8_STAGE
#undef PG8_LDA
#undef PG8_LDB
#undef PG8_MMA
#undef PG8_CAT
#undef PG8_WAIT_V
#undef PG8_WAIT_L
#undef PG8_BAR
#undef PG8_SCHED
}
}

struct GemmBase {
    static constexpr bool GATHER = false, FP8 = false; static constexpr int PERMK = 1;
    int nt; unsigned kstepA, kstepB; size_t hstepB; int G, c; int nostore = 0;
    unsigned lda2, hstepA, ldb2;
    __device__ __forceinline__ unsigned voffA(int R, int C, int h) const { return (unsigned)R * lda2 + (unsigned)C * 2u + (unsigned)h * hstepA; }
    __device__ __forceinline__ unsigned voffB(int Rb, int C) const { return (unsigned)Rb * ldb2 + (unsigned)C * 2u; }
    __device__ __forceinline__ unsigned gatherA(int, int, int, int) const { return 0u; }
    __device__ __forceinline__ void init_bytes(int Kbytes, int lda_bytes, int G_, int c_) {
        nt = Kbytes / 128; kstepA = 128u; kstepB = 128u; ldb2 = (unsigned)Kbytes; hstepB = (size_t)128 * Kbytes; lda2 = (unsigned)lda_bytes; hstepA = 128u * lda2; G = G_; c = c_; }
    __device__ __forceinline__ void init_plain(int K, int lda_elems, int G_, int c_) {
        nt = K / 64; kstepA = 128u; kstepB = 128u; ldb2 = (unsigned)K * 2u; hstepB = (size_t)128 * K * 2; lda2 = (unsigned)lda_elems * 2u; hstepA = 128u * lda2; G = G_; c = c_; }
};

struct GemmG1 : GemmBase {
    static constexpr bool FP8 = true; static constexpr int PERMK = 2;
    const unsigned char* A; const unsigned char* Bt; unsigned char* O; const float* bias;
    __device__ __forceinline__ bool next(int i, pg8::Unit& u) const { int pm, pn; if (!pg8::static_unit((long)i * G + c, NTOK / 256, 16, pm, pn)) return false;
        u.a = (const char*)A + (size_t)pm * 256 * D; u.b = (const char*)Bt + (size_t)pn * 256 * D; u.x = pm; u.y = pn; return true; }
    __device__ __forceinline__ void epi(const pg8::Acc& acc, const pg8::Unit& u, int wr, int wc, int fr, int fq) const {
        const int row0 = u.x * 256 + wr * 64 + fr, col0 = u.y * 256 + wc * 64 + 16 * fq;
        constexpr float SA = 1.0f / SC_AWI;
        f32x4 bv[2][2];
#pragma unroll
        for (int bj = 0; bj < 2; ++bj)
#pragma unroll
            for (int n = 0; n < 2; ++n) bv[bj][n] = *(const f32x4*)(bias + col0 + 8 * bj + 4 * n);
#pragma unroll
        for (int ai = 0; ai < 2; ++ai)
#pragma unroll
            for (int m = 0; m < 4; ++m) { u32x4 w;
#pragma unroll
                for (int bj = 0; bj < 2; ++bj) { const f32x4 v0 = acc[ai][bj][m][0] * SA + bv[bj][0], v1 = acc[ai][bj][m][1] * SA + bv[bj][1];
                    static_assert(SC_UV == 8.0f, "gelu2x8"); const f32x2 r0 = gelu2x8(LO2(v0)), r1 = gelu2x8(HI2(v0)), r2 = gelu2x8(LO2(v1)), r3 = gelu2x8(HI2(v1));
                    w[2 * bj] = pk4_fp8_nc(r0.x, r0.y, r1.x, r1.y); w[2 * bj + 1] = pk4_fp8_nc(r2.x, r2.y, r3.x, r3.y); }
                *(u32x4*)(O + (size_t)(row0 + ai * 128 + m * 16) * 4096 + col0) = w; }
    }
};

struct GemmG3 : GemmBase {
    static constexpr bool FP8 = true; static constexpr int PERMK = 2;
    const unsigned char* A; const unsigned char* Bt; bf16_t* Z; const bf16_t* R;
    __device__ __forceinline__ bool next(int i, pg8::Unit& u) const { int pm, pn; if (!pg8::static_unit((long)i * G + c, NTOK / 256, 8, pm, pn)) return false;
        u.a = (const char*)A + (size_t)pm * 256 * D; u.b = (const char*)Bt + (size_t)pn * 256 * D; u.x = pm; u.y = pn; return true; }
    __device__ __forceinline__ void epi(const pg8::Acc& acc, const pg8::Unit& u, int wr, int wc, int fr, int fq) const {
        const int row0 = u.x * 256 + wr * 64 + fr, col0 = u.y * 256 + wc * 64 + 16 * fq;
        constexpr float SM = SC_Z / (SC_P * SC_AWO);
        unsigned char* Z8 = (unsigned char*)Z;
#pragma unroll
        for (int ai = 0; ai < 2; ++ai)
#pragma unroll
            for (int m = 0; m < 4; ++m) { u32x4 w;
#pragma unroll
                for (int bj = 0; bj < 2; ++bj) { const f32x4 v0 = acc[ai][bj][m][0] * SM, v1 = acc[ai][bj][m][1] * SM; w[2 * bj] = pk4_fp8_nc(v0[0], v0[1], v0[2], v0[3]); w[2 * bj + 1] = pk4_fp8_nc(v1[0], v1[1], v1[2], v1[3]); }
                *(u32x4*)(Z8 + (size_t)(row0 + ai * 128 + m * 16) * D + col0) = w; }
    }
};

struct GemmS1 : GemmBase {
    static constexpr bool FP8 = true; static constexpr int PERMK = 2;
    const unsigned char* A; const unsigned char* Bt; bf16_t* A2;
    __device__ __forceinline__ bool next(int i, pg8::Unit& u) const { int pm, pn; if (!pg8::static_unit((long)i * G + c, NTOK / 256, 4, pm, pn)) return false;
        u.a = (const char*)A + (size_t)pm * 256 * D; u.b = (const char*)Bt + (size_t)pn * 256 * D; u.x = pm; u.y = pn; return true; }
    __device__ __forceinline__ void epi(const pg8::Acc& acc, const pg8::Unit& u, int wr, int wc, int fr, int fq) const {
        const int row0 = u.x * 256 + wr * 64 + fr, col0 = u.y * 256 + wc * 64 + 16 * fq;
        constexpr float SU = 1.0f / SC_BW;
        const int gg = col0 >> 4;
#pragma unroll
        for (int ai = 0; ai < 2; ++ai)
#pragma unroll
            for (int m = 0; m < 4; ++m) { const int tok = row0 + ai * 128 + m * 16; const int rr = tok >> 4, ii = tok & 15; bf16_t* dst = A2 + ((size_t)gg * 2048 + rr) * 384 + ii * 16;
#pragma unroll
                for (int bj = 0; bj < 2; ++bj) { const f32x4 v0 = acc[ai][bj][m][0] * SU, v1 = acc[ai][bj][m][1] * SU;
                    u32x4 w; w.x = cvt_pk_bf16(v0[0], v0[1]); w.y = cvt_pk_bf16(v0[2], v0[3]); w.z = cvt_pk_bf16(v1[0], v1[1]); w.w = cvt_pk_bf16(v1[2], v1[3]);
                    *(u32x4*)(dst + bj * 8) = w; } }
    }
};

struct GemmS2 : GemmBase {
    static constexpr int PERMK = 0;
    const bf16_t* A2; const bf16_t* Et; float* Xend;
    __device__ __forceinline__ bool next(int i, pg8::Unit& u) const { const long v = (long)i * G + c; if (v >= 512) return false; const int gg = (int)(v >> 3), pm = (int)(v & 7);
        u.a = (const char*)A2 + ((size_t)gg * 2048 + pm * 256) * 384 * 2; u.b = (const char*)Et + (size_t)gg * 256 * 256 * 2; u.x = gg; u.y = pm; return true; }
    __device__ __forceinline__ void epi(const pg8::Acc& acc, const pg8::Unit& u, int wr, int wc, int fr, int fq) const {
        const int row0 = u.y * 256 + wr * 64 + fr, col0 = wc * 32 + 4 * fq;
#pragma unroll
        for (int ai = 0; ai < 2; ++ai)
#pragma unroll
            for (int m = 0; m < 4; ++m) { float* rowp = Xend + ((size_t)u.x * 2048 + row0 + ai * 128 + m * 16) * 128 + col0;
#pragma unroll
                for (int n = 0; n < 2; ++n) *(f32x4*)(rowp + n * 16) = acc[ai][0][m][n]; }
    }
};

struct GemmS4 : GemmBase {
    static constexpr int PERMK = 2;
    const bf16_t* A2; const bf16_t* Bs; unsigned char* Y;
    __device__ __forceinline__ bool next(int i, pg8::Unit& u) const { const long v = (long)i * G + c; if (v >= 512) return false; const int gg = (int)(v >> 3), pm = (int)(v & 7);
        u.a = (const char*)A2 + ((size_t)gg * 2048 + pm * 256) * 384 * 2; u.b = (const char*)Bs + (size_t)gg * 256 * 384 * 2; u.x = gg; u.y = pm; return true; }
    __device__ __forceinline__ void epi(const pg8::Acc& acc, const pg8::Unit& u, int wr, int wc, int fr, int fq) const {
        const int row0 = u.y * 256 + wr * 64 + fr, col0 = wc * 64 + 16 * fq;
#pragma unroll
        for (int ai = 0; ai < 2; ++ai)
#pragma unroll
            for (int m = 0; m < 4; ++m) { u32x4 w;
#pragma unroll
                for (int bj = 0; bj < 2; ++bj) { const f32x4 v0 = acc[ai][bj][m][0], v1 = acc[ai][bj][m][1];
                    static_assert(SC_YS == 8.0f, "gelu2x8"); const f32x2 r0 = gelu2x8(LO2(v0)), r1 = gelu2x8(HI2(v0)), r2 = gelu2x8(LO2(v1)), r3 = gelu2x8(HI2(v1));
                    w[2 * bj] = pk4_fp8_nc(r0.x, r0.y, r1.x, r1.y); w[2 * bj + 1] = pk4_fp8_nc(r2.x, r2.y, r3.x, r3.y); }
                *(u32x4*)(Y + ((size_t)u.x * 2048 + row0 + ai * 128 + m * 16) * 256 + col0) = w; }
    }
};

struct GemmS5 : GemmBase {
    static constexpr bool FP8 = true;
    const unsigned char* Y; const unsigned char* Bt; bf16_t* Z; const bf16_t* R;
    __device__ __forceinline__ unsigned voffA(int Rr, int C, int h) const { return (unsigned)((C >> 3) * 2048 * 256 + (Rr >> 4) * 256 + (Rr & 15) * 16 + h * 2048); }
    __device__ __forceinline__ bool next(int i, pg8::Unit& u) const { int pm, pn; if (!pg8::static_unit((long)i * G + c, NTOK / 256, 16, pm, pn)) return false;
        u.a = (const char*)Y + (size_t)pm * 16 * 256; u.b = (const char*)Bt + (size_t)pn * 256 * BW; u.x = pm; u.y = pn; return true; }
    __device__ __forceinline__ void epi(const pg8::Acc& acc, const pg8::Unit& u, int wr, int wc, int fr, int fq) const {
        const int row0 = u.x * 256 + wr * 64 + fr, col0 = u.y * 128 + wc * 32 + 8 * fq;
        constexpr float SV = 1.0f / (SC_YS * SC_BW);
#pragma unroll
        for (int ai = 0; ai < 2; ++ai)
#pragma unroll
            for (int m = 0; m < 4; ++m) { const size_t off = (size_t)(row0 + ai * 128 + m * 16) * D + col0;
                const f32x4 a0 = acc[ai][0][m][0] * SV, a1 = acc[ai][0][m][1] * SV, g0 = acc[ai][1][m][0] * SV, g1 = acc[ai][1][m][1] * SV;
                const f32x2 r0 = LO2(a0) * sig2(LO2(g0)) * SC_Z, r1 = HI2(a0) * sig2(HI2(g0)) * SC_Z, r2 = LO2(a1) * sig2(LO2(g1)) * SC_Z, r3 = HI2(a1) * sig2(HI2(g1)) * SC_Z;
                u32x2 w; w.x = pk4_fp8_nc(r0.x, r0.y, r1.x, r1.y); w.y = pk4_fp8_nc(r2.x, r2.y, r3.x, r3.y);
                *(u32x2*)((unsigned char*)Z + off) = w; }
    }
};

struct MoeTab { const LAS int* tp; const LAS int* sb; const LAS int* cnt; int nU; };
__device__ __forceinline__ bool moe_unit(const MoeTab& T, long L, int& e, int& mt, int& pn) {
    const int nU = T.nU; if (L >= nU) return false;
    int v; { const int q = nU / 8, r = nU % 8, xcd = (int)(L % 8), off = (int)(L / 8); v = (xcd < r ? xcd * (q + 1) : r * (q + 1) + (xcd - r) * q) + off; }
    const int tile = v >> 3;
    int ee = 0;
#pragma unroll
    for (int j = 1; j < 16; ++j) ee += (tile >= __builtin_amdgcn_readfirstlane(T.tp[j])) ? 1 : 0;
    const int tp0 = __builtin_amdgcn_readfirstlane(T.tp[ee]), tp1 = __builtin_amdgcn_readfirstlane(T.tp[ee + 1]);
    const int tiles_e = tp1 - tp0, ve = v - 8 * tp0;
    const int gid = ve >> 6, fm = gid * 8, gsz = (tiles_e - fm) < 8 ? (tiles_e - fm) : 8, rem = ve - 64 * gid;
    e = ee; mt = fm + rem % gsz; pn = rem / gsz; return true;
}

struct GemmM1 : GemmBase {
    static constexpr bool GATHER = true, FP8 = true;
    const unsigned char* H8; const unsigned char* Bt; unsigned char* ACT; MoeTab T; const LAS int* rows;
    __device__ __forceinline__ unsigned gatherA(int ui, int Rr, int C, int h) const { return (unsigned)rows[ui * 256 + h * 128 + Rr] * (unsigned)D + (unsigned)C * 2u; }
    __device__ __forceinline__ bool next(int i, pg8::Unit& u) const { int e, mt, pn; if (!moe_unit(T, (long)i * G + c, e, mt, pn)) return false;
        u.a = (const char*)H8; u.b = (const char*)Bt + ((size_t)e * 2048 + pn * 256) * D; u.x = __builtin_amdgcn_readfirstlane(T.sb[e]) + mt * 256; u.y = pn; u.z = e; u.w = mt; return true; }
    __device__ __forceinline__ void epi(const pg8::Acc& acc, const pg8::Unit& u, int wr, int wc, int fr, int fq) const {
        const int row0 = u.x + wr * 64 + fr, col0 = u.y * 128 + wc * 32 + 8 * fq;
        constexpr float SG = 1.0f / SC_WIN, SU = SC_ACT / SC_WIN;
#pragma unroll
        for (int ai = 0; ai < 2; ++ai)
#pragma unroll
            for (int m = 0; m < 4; ++m) { const f32x4 a0 = acc[ai][0][m][0] * SG, a1 = acc[ai][0][m][1] * SG, u0 = acc[ai][1][m][0] * SU, u1 = acc[ai][1][m][1] * SU;
                const f32x2 r0 = LO2(a0) * sig2(LO2(a0)) * LO2(u0), r1 = HI2(a0) * sig2(HI2(a0)) * HI2(u0), r2 = LO2(a1) * sig2(LO2(a1)) * LO2(u1), r3 = HI2(a1) * sig2(HI2(a1)) * HI2(u1);
                u32x2 w; w.x = pk4_fp8(r0.x, r0.y, r1.x, r1.y); w.y = pk4_fp8(r2.x, r2.y, r3.x, r3.y);
                *(u32x2*)(ACT + (size_t)(row0 + ai * 128 + m * 16) * DFF + col0) = w; }
    }
};
struct GemmM2 : GemmBase {
    static constexpr bool FP8 = true; static constexpr int PERMK = 2;
    const unsigned char* ACT; const unsigned char* Bt; unsigned char* YB; MoeTab T;
    __device__ __forceinline__ bool next(int i, pg8::Unit& u) const { int e, mt, pn; if (!moe_unit(T, (long)i * G + c, e, mt, pn)) return false;
        const int r0 = __builtin_amdgcn_readfirstlane(T.sb[e]) + mt * 256; u.a = (const char*)ACT + (size_t)r0 * DFF; u.b = (const char*)Bt + ((size_t)e * 2048 + pn * 256) * DFF; u.x = r0; u.y = pn; return true; }
    __device__ __forceinline__ void epi(const pg8::Acc& acc, const pg8::Unit& u, int wr, int wc, int fr, int fq) const {
        const int row0 = u.x + wr * 64 + fr, col0 = u.y * 256 + wc * 64 + 16 * fq;
        constexpr float SY = SC_Y / (SC_ACT * SC_WOUT);
#pragma unroll
        for (int ai = 0; ai < 2; ++ai)
#pragma unroll
            for (int m = 0; m < 4; ++m) { u32x4 w;
#pragma unroll
                for (int bj = 0; bj < 2; ++bj) { const f32x4 v0 = acc[ai][bj][m][0] * SY, v1 = acc[ai][bj][m][1] * SY;
                    w[2 * bj] = pk4_fp8_nc(v0[0], v0[1], v0[2], v0[3]); w[2 * bj + 1] = pk4_fp8_nc(v1[0], v1[1], v1[2], v1[3]); }
                *(u32x4*)(YB + (size_t)(row0 + ai * 128 + m * 16) * D + col0) = w; }
    }
};

struct Args { const float* in[26]; float* out; unsigned char* ws; int ph_lo, ph_hi, flags, pad; };
struct Frame {
    LAS unsigned char* lds; unsigned char* ws; unsigned* ctl;
    int tid, lane, wave, G, bx;
};

__device__ __forceinline__ void transpose_item(const float* __restrict__ src, int ldsrc, int k0, int srccol0, bf16_t* __restrict__ dst, int ldt, int dstrow0, LAS unsigned char* scr, int tid) {
    const int a = tid >> 5, nq = tid & 31;
    f32x4 v[8];
#pragma unroll
    for (int r = 0; r < 8; ++r) v[r] = *(const f32x4*)(src + (size_t)(k0 + 8 * a + r) * ldsrc + srccol0 + 4 * nq);
#pragma unroll
    for (int j = 0; j < 4; ++j) { u32x4 w; w.x = cvt_pk_bf16(v[0][j], v[1][j]); w.y = cvt_pk_bf16(v[2][j], v[3][j]); w.z = cvt_pk_bf16(v[4][j], v[5][j]); w.w = cvt_pk_bf16(v[6][j], v[7][j]);
        const int n = 4 * nq + j; *(LAS u32x4*)(scr + n * 256 + ((a ^ ((n >> 2) & 15)) << 4)) = w; }
    __syncthreads();
#pragma unroll
    for (int q = 0; q < 4; ++q) { const int idx = tid + 512 * q, n = idx >> 4, ch = idx & 15;
        const u32x4 w = *(const LAS u32x4*)(scr + n * 256 + ((ch ^ ((n >> 2) & 15)) << 4));
        *(u32x4*)(dst + (size_t)(dstrow0 + n) * ldt + k0 + 8 * ch) = w; }
    __syncthreads();
}
__device__ __forceinline__ void transpose_item_f8(const float* __restrict__ src, int ldsrc, int k0, int srccol0, unsigned char* __restrict__ dst, int ldt, int dstrow0, float sc, LAS unsigned char* scr, int tid) {
    const int a = tid >> 5, nq = tid & 31;
#pragma unroll
    for (int h = 0; h < 2; ++h) {
        f32x4 v[8];
#pragma unroll
        for (int r = 0; r < 8; ++r) v[r] = *(const f32x4*)(src + (size_t)(k0 + 128 * h + 8 * a + r) * ldsrc + srccol0 + 4 * nq) * sc;
#pragma unroll
        for (int j = 0; j < 4; ++j) { u32x2 w; w.x = pk4_fp8(v[0][j], v[1][j], v[2][j], v[3][j]); w.y = pk4_fp8(v[4][j], v[5][j], v[6][j], v[7][j]);
            const int n = 4 * nq + j, c16 = 8 * h + (a >> 1); *(LAS u32x2*)(scr + n * 256 + ((c16 ^ ((n >> 2) & 15)) << 4) + (a & 1) * 8) = w; }
    }
    __syncthreads();
#pragma unroll
    for (int q = 0; q < 4; ++q) { const int idx = tid + 512 * q, n = idx >> 4, ch = idx & 15;
        const u32x4 w = *(const LAS u32x4*)(scr + n * 256 + ((ch ^ ((n >> 2) & 15)) << 4));
        *(u32x4*)(dst + (size_t)(dstrow0 + n) * ldt + k0 + 16 * ch) = w; }
    __syncthreads();
}
__device__ __forceinline__ void transpose_job_f8(Frame& F, const float* src, unsigned char* dst, int nmat, int K, int N, bool glu, float sc, int& itbase) {
    const int kb = K / 256, nb = N / 128, per = kb * nb, total = nmat * per;
    int first = (F.bx - itbase % F.G + F.G) % F.G;
    for (int it = first; it < total; it += F.G) {
        const int m = it / per, r = it % per, kk = r / nb, nn = r % nb;
        const int srccol0 = glu ? ((nn & 1) * (N / 2) + (nn >> 1) * 128) : nn * 128;
        transpose_item_f8(src + (size_t)m * K * N, N, kk * 256, srccol0, dst + (size_t)m * K * N, K, nn * 128, sc, F.lds, F.tid);
    }
    itbase += total;
}
__device__ __forceinline__ void transpose_job(Frame& F, const float* src, bf16_t* dst, int nmat, int K, int N, bool glu, int& itbase) {
    const int kb = K / 128, nb = N / 128, per = kb * nb, total = nmat * per;
    int first = (F.bx - itbase % F.G + F.G) % F.G;
    for (int it = first; it < total; it += F.G) {
        const int m = it / per, r = it % per, kk = r / nb, nn = r % nb;
        const int srccol0 = glu ? ((nn & 1) * (N / 2) + (nn >> 1) * 128) : nn * 128;
        transpose_item(src + (size_t)m * K * N, N, kk * 128, srccol0, dst + (size_t)m * K * N, K, nn * 128, F.lds, F.tid);
    }
    itbase += total;
}

__device__ __forceinline__ void ssm_precompute(Frame& F, const float* const* in, int g) {
    const float* a_re = in[9]; const float* a_im = in[10]; const float* log_dt = in[11]; const float* b_re = in[12]; const float* b_im = in[13];
    const float* c_re = in[14]; const float* c_im = in[15]; const float* dsk = in[16];
    LAS float* PW = (LAS float*)F.lds;
    LAS float* BB = PW + 64 * 17 * 2;
    LAS float* CC = BB + 64 * 16 * 2;
    LAS float* KM = CC + 16 * 64 * 2;
    bf16_t* Bs = (bf16_t*)(F.ws + WS_SSMB) + (size_t)g * 256 * 384;
    bf16_t* Et = (bf16_t*)(F.ws + WS_SSME) + (size_t)g * 256 * 256;
    const float dt = expf(log_dt[g]);
    __syncthreads();
    for (int idx = F.tid; idx < 64 * 17; idx += NTHR) { const int p = idx / 17, k = idx % 17; const float zr = a_re[g * 64 + p] * dt * (float)k, zi = a_im[g * 64 + p] * dt * (float)k;
        const float mag = expf(zr); float sn, cs; sincosf(zi, &sn, &cs); PW[idx * 2] = mag * cs; PW[idx * 2 + 1] = mag * sn; }
    for (int idx = F.tid; idx < 64 * 16; idx += NTHR) { const int p = idx >> 4, c = idx & 15; const float ar = a_re[g * 64 + p], ai = a_im[g * 64 + p];
        const float zr = ar * dt, zi = ai * dt; const float mag = expf(zr); float sn, cs; sincosf(zi, &sn, &cs);
        const float nr = mag * cs - 1.0f, ni = mag * sn;
        const float den = 1.0f / (ar * ar + ai * ai); const float qr = (nr * ar + ni * ai) * den, qi = (ni * ar - nr * ai) * den;
        const float br = b_re[(g * 64 + p) * 16 + c], bi = b_im[(g * 64 + p) * 16 + c];
        BB[idx * 2] = qr * br - qi * bi; BB[idx * 2 + 1] = qr * bi + qi * br; }
    for (int idx = F.tid; idx < 16 * 64; idx += NTHR) { const int c = idx >> 6, p = idx & 63; CC[idx * 2] = c_re[(g * 16 + c) * 64 + p]; CC[idx * 2 + 1] = c_im[(g * 16 + c) * 64 + p]; }
    __syncthreads();
    for (int idx = F.tid; idx < 4096; idx += NTHR) { const int k = idx >> 8, c = (idx >> 4) & 15, cp = idx & 15; float s = 0.f;
        for (int p = 0; p < 64; ++p) { const float cr = CC[(c * 64 + p) * 2], ci = CC[(c * 64 + p) * 2 + 1], pr = PW[(p * 17 + k) * 2], pi = PW[(p * 17 + k) * 2 + 1], br = BB[(p * 16 + cp) * 2], bi = BB[(p * 16 + cp) * 2 + 1];
            const float tr = cr * pr - ci * pi, ti = cr * pi + ci * pr; s += tr * br - ti * bi; }
        KM[idx] = s; }
    __syncthreads();
    for (int idx = F.tid; idx < 256 * 256; idx += NTHR) { const int n = idx >> 8, kq = idx & 255, i = n >> 4, c = n & 15, ip = kq >> 4, cp = kq & 15;
        float v = 0.f; if (ip <= i) v = KM[((i - ip) * 16 + c) * 16 + cp]; if (ip == i && c == cp) v += dsk[g * 16 + c];
        Bs[(size_t)n * 384 + kq] = (bf16_t)f2bf(v); }
    for (int idx = F.tid; idx < 256 * 64; idx += NTHR) { const int n = idx >> 6, p = idx & 63, i = n >> 4, c = n & 15;
        const float cr = CC[(c * 64 + p) * 2], ci = CC[(c * 64 + p) * 2 + 1], pr = PW[(p * 17 + i + 1) * 2], pi = PW[(p * 17 + i + 1) * 2 + 1];
        Bs[(size_t)n * 384 + 256 + p] = (bf16_t)f2bf(cr * pr - ci * pi); Bs[(size_t)n * 384 + 320 + p] = (bf16_t)f2bf(-(cr * pi + ci * pr)); }
    for (int idx = F.tid; idx < 256 * 256; idx += NTHR) { const int n = idx >> 8, kq = idx & 255, ip = kq >> 4, cp = kq & 15; float v = 0.f;
        if (n < 128) { const int p = n & 63; const float pr = PW[(p * 17 + 15 - ip) * 2], pi = PW[(p * 17 + 15 - ip) * 2 + 1], br = BB[(p * 16 + cp) * 2], bi = BB[(p * 16 + cp) * 2 + 1];
            v = (n < 64) ? (pr * br - pi * bi) : (pr * bi + pi * br); }
        Et[(size_t)n * 256 + kq] = (bf16_t)f2bf(v); }
    __syncthreads();
}

__device__ __forceinline__ void p0_prologue(Frame& F, const float* const* in) {
    unsigned char* ws = F.ws;
    if (F.bx < 64) ssm_precompute(F, in, F.bx);
    { const float* w_s = in[5]; bf16_t* wt = (bf16_t*)(ws + WS_WTRIL);
      for (int idx = F.bx * NTHR + F.tid; idx < 8 * 128 * 128; idx += F.G * NTHR) { const int t = (idx >> 7) & 127, s = idx & 127; wt[idx] = (s <= t) ? (bf16_t)f2bf(w_s[idx]) : (bf16_t)0; } }
    { const float* rw = in[20]; u32x4* rwf = (u32x4*)(ws + WS_RWF);
      for (int idx = F.bx * NTHR + F.tid; idx < 8 * 8 * 64; idx += F.G * NTHR) { const int ln = idx & 63, kk = (idx >> 6) & 7, wv = idx >> 9, e = ln & 15, q = ln >> 4;
          unsigned hi[8], lo[8];
#pragma unroll
          for (int j = 0; j < 8; ++j) { const float w = rw[(size_t)(256 * wv + 32 * kk + 8 * q + j) * 16 + e]; hi[j] = f2bf(w); lo[j] = f2bf(w - __uint_as_float(hi[j] << 16)); }
          rwf[((wv * 8 + kk) * 2) * 64 + ln] = (u32x4){hi[0] | (hi[1] << 16), hi[2] | (hi[3] << 16), hi[4] | (hi[5] << 16), hi[6] | (hi[7] << 16)};
          rwf[((wv * 8 + kk) * 2 + 1) * 64 + ln] = (u32x4){lo[0] | (lo[1] << 16), lo[2] | (lo[3] << 16), lo[4] | (lo[5] << 16), lo[6] | (lo[7] << 16)}; } }
    int itbase = 0;
    transpose_job_f8(F, in[1], ws + WS_WIN, 1, 2048, 4096, false, SC_AWI, itbase);
    transpose_job_f8(F, in[7], ws + WS_WOUT, 1, 2048, 2048, false, SC_AWO, itbase);
    transpose_job_f8(F, in[8], ws + WS_BWIN, 1, 2048, 1024, false, SC_BW, itbase);
    transpose_job_f8(F, in[17], ws + WS_BWOUT, 1, 1024, 4096, true, SC_BW, itbase);
    { const float* x = in[0]; bf16_t* xb = (bf16_t*)(ws + WS_A); unsigned char* x8 = ws + WS_X8;
      constexpr int NBLK = (int)((size_t)NTOK * D / 8 / 2048);
      LAS int* qv = (LAS int*)(F.lds + LDS_MOE + 448);
      for (;;) { __syncthreads(); if (F.tid == 0) *qv = (int)__hip_atomic_fetch_add(F.ctl + CW_XQ, 1u, __ATOMIC_RELAXED, __HIP_MEMORY_SCOPE_AGENT);
          __syncthreads(); const int blk = __builtin_amdgcn_readfirstlane(*qv); if (blk >= NBLK) break;
          f32x4 a[4], b[4];
#pragma unroll
          for (int q = 0; q < 4; ++q) { const size_t i = (size_t)blk * 2048 + q * 512 + F.tid; a[q] = *(const f32x4*)(x + i * 8); b[q] = *(const f32x4*)(x + i * 8 + 4); }
#pragma unroll
          for (int q = 0; q < 4; ++q) { const size_t i = (size_t)blk * 2048 + q * 512 + F.tid;
              u32x4 w; w.x = cvt_pk_bf16(a[q][0], a[q][1]); w.y = cvt_pk_bf16(a[q][2], a[q][3]); w.z = cvt_pk_bf16(b[q][0], b[q][1]); w.w = cvt_pk_bf16(b[q][2], b[q][3]); *(u32x4*)(xb + i * 8) = w;
              u32x2 w8; w8.x = pk4_fp8(a[q][0], a[q][1], a[q][2], a[q][3]); w8.y = pk4_fp8(b[q][0], b[q][1], b[q][2], b[q][3]); *(u32x2*)(x8 + i * 8) = w8; } } }
}

__device__ __forceinline__ int fV(int d) { return (d & 3) | (((d >> 4) & 3) << 2); }
__device__ __forceinline__ void g2_phase(Frame& F, const float* const* in) {
    const unsigned char* UV = F.ws + WS_B; const bf16_t* WT = (const bf16_t*)(F.ws + WS_WTRIL); unsigned char* P8 = F.ws + WS_H8;
    const float* lng = in[3]; const float* lnb = in[4]; const float* b_s = in[6];
    LAS unsigned char* VT = F.lds;
    LAS unsigned char* WSM = F.lds + 65536;
    LAS float* ST = (LAS float*)(F.lds + 98304);
    const int tid = F.tid, lane = F.lane, wave = F.wave, fr = lane & 15, fq = lane >> 4;
    const int sblk = tid >> 5, dblk = tid & 31;
    for (int ch = F.bx; ch < NTOK / CHUNK; ch += F.G) {
        const int tok0 = ch * CHUNK;
        const unsigned char* cUV = UV + (size_t)tok0 * 4096; unsigned char* cP8 = P8 + (size_t)tok0 * D;
        __syncthreads();
#pragma unroll 1
        for (int hb = 0; hb < 2; ++hb) {
            u32x4 w[8][2];
            unsigned so = (unsigned)((wave * 16 + hb * 8) * 4096 + 2048 + lane * 16); asm volatile("" : "+v"(so));
#pragma unroll
            for (int rr = 0; rr < 8; ++rr) { w[rr][0] = *(const u32x4*)(cUV + (so + rr * 4096u)); w[rr][1] = *(const u32x4*)(cUV + (so + rr * 4096u + 1024u)); }
#pragma unroll
            for (int rr = 0; rr < 8; ++rr) { float s = 0.f, s2 = 0.f;
#pragma unroll
                for (int j = 0; j < 2; ++j)
#pragma unroll
                    for (int q = 0; q < 4; ++q) { float f[4]; unpk4_fp8(w[rr][j][q], f);
#pragma unroll
                        for (int e = 0; e < 4; ++e) { s += f[e]; s2 += f[e] * f[e]; } }
                s = wave_sum(s) * (1.0f / SC_UV); s2 = wave_sum(s2) * (1.0f / (SC_UV * SC_UV));
                const float mu = s * (1.0f / 2048.0f), var = s2 * (1.0f / 2048.0f) - mu * mu; const int r = wave * 16 + hb * 8 + rr;
                if (lane == 0) { ST[r * 2] = mu; ST[r * 2 + 1] = 1.0f / sqrtf(fmaxf(var, 0.f) + LN_EPS); } }
        }
        u32x4 wreg[4]; u32x2 vreg[8]; f32x4 gbr[4];
#define G2_LOAD(gg) do { _Pragma("unroll") for (int q = 0; q < 4; ++q) { const int idx = tid + 512 * q; wreg[q] = *(const u32x4*)(WT + ((size_t)(gg) * 128 + (idx >> 4)) * 128 + (idx & 15) * 8); } \
            const int dc_ = (gg) * 256 + dblk * 8; unsigned vo_ = (unsigned)(sblk * 8 * 4096 + 2048 + dc_); asm volatile("" : "+v"(vo_)); \
            _Pragma("unroll") for (int r = 0; r < 8; ++r) vreg[r] = *(const u32x2*)(cUV + (vo_ + r * 4096u)); \
            gbr[0] = *(const f32x4*)(lng + dc_); gbr[1] = *(const f32x4*)(lng + dc_ + 4); gbr[2] = *(const f32x4*)(lnb + dc_); gbr[3] = *(const f32x4*)(lnb + dc_ + 4); } while (0)
        G2_LOAD(0);
        __syncthreads();
#pragma unroll 1
        for (int g = 0; g < AG; ++g) {
#pragma unroll
            for (int q = 0; q < 4; ++q) { const int idx = tid + 512 * q, t = idx >> 4, c16 = idx & 15; *(LAS u32x4*)(WSM + t * 256 + ((c16 ^ (t & 15)) << 4)) = wreg[q]; }
            { unsigned pk[4][8];
#pragma unroll
              for (int rp = 0; rp < 4; ++rp) { const int s0 = sblk * 8 + 2 * rp; const f32x4 st = *(const LAS f32x4*)(ST + s0 * 2);
                  float f0[8], f1[8]; unpk4_fp8(vreg[2 * rp].x, f0); unpk4_fp8(vreg[2 * rp].y, f0 + 4); unpk4_fp8(vreg[2 * rp + 1].x, f1); unpk4_fp8(vreg[2 * rp + 1].y, f1 + 4);
#pragma unroll
                  for (int q = 0; q < 8; ++q) { const float gq = gbr[q >> 2][q & 3], bq = gbr[2 + (q >> 2)][q & 3];
                      pk[rp][q] = cvt_pk_bf16((f0[q] * (1.0f / SC_UV) - st[0]) * st[1] * gq + bq, (f1[q] * (1.0f / SC_UV) - st[2]) * st[3] * gq + bq); } }
#pragma unroll
              for (int j = 0; j < 8; ++j) { const int d = dblk * 8 + j; u32x4 w; w.x = pk[0][j]; w.y = pk[1][j]; w.z = pk[2][j]; w.w = pk[3][j];
                  *(LAS u32x4*)(VT + d * 256 + ((sblk ^ fV(d)) << 4)) = w; } }
            __syncthreads();
            if (g + 1 < AG) G2_LOAD(g + 1);
            const int wd = wave & 3, wt = wave >> 2;
            u32x4 ureg[4]; float bsr[4];
            unsigned uo = (unsigned)(fr * 4096 + g * 256 + wd * 64 + 16 * fq); asm volatile("" : "+v"(uo));
#pragma unroll
            for (int mi = 0; mi < 4; ++mi) { const int m = 2 * mi + (((mi & 1) ^ wt) ? 1 : 0); ureg[mi] = *(const u32x4*)(cUV + (uo + (unsigned)m * 65536u)); bsr[mi] = b_s[g * 128 + 16 * m + fr]; }
            f32x4 acc[4][4];
#pragma unroll
            for (int mi = 0; mi < 4; ++mi)
#pragma unroll
                for (int n = 0; n < 4; ++n) acc[mi][n] = (f32x4){0.f, 0.f, 0.f, 0.f};
#pragma unroll
            for (int ks = 0; ks < 4; ++ks) {
                bf16x8 bfr[4];
#pragma unroll
                for (int n = 0; n < 4; ++n) { const int d = wd * 64 + 16 * (fr >> 2) + 4 * n + (fr & 3); bfr[n] = *(const LAS bf16x8*)(VT + d * 256 + (((4 * ks + fq) ^ fV(d)) << 4)); }
#pragma unroll
                for (int mi = 0; mi < 4; ++mi) { const int m = 2 * mi + (((mi & 1) ^ wt) ? 1 : 0);
                    if (m >= 2 * ks) { const int t = 16 * m + fr; const bf16x8 afr = *(const LAS bf16x8*)(WSM + t * 256 + (((4 * ks + fq) ^ (t & 15)) << 4));
#pragma unroll
                        for (int n = 0; n < 4; ++n) acc[mi][n] = __builtin_amdgcn_mfma_f32_16x16x32_bf16(bfr[n], afr, acc[mi][n], 0, 0, 0); } }
            }
            unsigned po = (unsigned)(fr * D + g * 256 + wd * 64 + 16 * fq); asm volatile("" : "+v"(po));
#pragma unroll
            for (int mi = 0; mi < 4; ++mi) { const int m = 2 * mi + (((mi & 1) ^ wt) ? 1 : 0); const float bs = bsr[mi]; constexpr float SPU = SC_P / SC_UV; u32x4 w;
#pragma unroll
                for (int n = 0; n < 4; ++n) { float f[4]; unpk4_fp8(ureg[mi][n], f);
                    w[n] = pk4_fp8(SPU * f[0] * (acc[mi][n][0] + bs), SPU * f[1] * (acc[mi][n][1] + bs), SPU * f[2] * (acc[mi][n][2] + bs), SPU * f[3] * (acc[mi][n][3] + bs)); }
                *(u32x4*)(cP8 + (po + (unsigned)m * 16u * D)) = w; }
            __syncthreads();
        }
#undef G2_LOAD
    }
}

__device__ __forceinline__ void ln_route_phase(Frame& F, const float* const* in, int layer) {
    const bf16_t* Z = (const bf16_t*)(F.ws + WS_C); const bf16_t* RES = (const bf16_t*)(F.ws + WS_A); bf16_t* H = (bf16_t*)(F.ws + WS_D); unsigned char* H8 = F.ws + WS_H8;
    const float* lng = in[18] + layer * D; const float* lnb = in[19] + layer * D; const float* rw = in[20]; const float* rb = in[21];
    int* rowlist = (int*)(F.ws + WS_ROWLIST); i32x4* toki = (i32x4*)(F.ws + WS_TOKI); f32x2* tokg = (f32x2*)(F.ws + WS_TOKG);
    unsigned* gcnt = F.ctl + CW_CNT + 64 * layer;
    LAS unsigned char* T = F.lds;
    LAS float* PART = (LAS float*)(F.lds + 65792);
    LAS int* LCNT = (LAS int*)(F.lds + 65792 + 8192);
    LAS int* LBASE = LCNT + 16;
    LAS int* TE = LBASE + 16;
    LAS int* TR = TE + 512;
    const int tid = F.tid, lane = F.lane, wave = F.wave, fr = lane & 15, fq = lane >> 4;
    bf16x8 rwh[8], rwl[8];
    { const bf16x8* rwf = (const bf16x8*)(F.ws + WS_RWF) + (size_t)wave * 8 * 2 * 64 + lane;
#pragma unroll
      for (int kk = 0; kk < 8; ++kk) { rwh[kk] = rwf[(kk * 2) * 64]; rwl[kk] = rwf[(kk * 2 + 1) * 64]; } }
    LAS float* GB = (LAS float*)(F.lds + 81920);
    __syncthreads();
    for (int i = tid; i < D / 4; i += NTHR) { *(LAS f32x4*)(GB + 4 * i) = *(const f32x4*)(lng + 4 * i); *(LAS f32x4*)(GB + D + 4 * i) = *(const f32x4*)(lnb + 4 * i); }
    if (tid < 16) LCNT[tid] = 0;
    __syncthreads();
    int nloc = 0;
    for (int it = 0, grp = F.bx; grp < NTOK / 16; ++it, grp += F.G) {
#pragma unroll 1
        for (int rr = 0; rr < 2; ++rr) { const int r = 2 * wave + rr; const size_t tok = (size_t)grp * 16 + r; const bf16_t* zp = Z + tok * D; const bf16_t* rp = RES + tok * D;
            float x[4][8]; float s = 0.f;
#pragma unroll
            for (int j = 0; j < 4; ++j) { const u32x2 w = *(const u32x2*)((const unsigned char*)Z + tok * D + (j * 64 + lane) * 8); const u32x4 rv = *(const u32x4*)(rp + (j * 64 + lane) * 8);
                float f[8]; unpk4_fp8(w.x, f); unpk4_fp8(w.y, f + 4);
#pragma unroll
                for (int q = 0; q < 4; ++q) { x[j][2 * q] = ALPHA * bf_lo(rv[q]) + f[2 * q] * (1.0f / SC_Z); x[j][2 * q + 1] = ALPHA * bf_hi(rv[q]) + f[2 * q + 1] * (1.0f / SC_Z); s += x[j][2 * q] + x[j][2 * q + 1]; } }
            const float mu = wave_sum(s) * (1.0f / D); float s2 = 0.f;
#pragma unroll
            for (int j = 0; j < 4; ++j)
#pragma unroll
                for (int q = 0; q < 8; ++q) { x[j][q] -= mu; s2 += x[j][q] * x[j][q]; }
            const float rs = 1.0f / sqrtf(wave_sum(s2) * (1.0f / D) + LN_EPS);
#pragma unroll
            for (int j = 0; j < 4; ++j) { const int c0 = (j * 64 + lane) * 8;
                const f32x4 g0 = *(const LAS f32x4*)(GB + c0), g1 = *(const LAS f32x4*)(GB + c0 + 4), b0 = *(const LAS f32x4*)(GB + D + c0), b1 = *(const LAS f32x4*)(GB + D + c0 + 4);
                float o[8];
#pragma unroll
                for (int q = 0; q < 4; ++q) { o[q] = x[j][q] * rs * g0[q] + b0[q]; o[4 + q] = x[j][4 + q] * rs * g1[q] + b1[q]; }
                u32x4 w; w.x = cvt_pk_bf16(o[0], o[1]); w.y = cvt_pk_bf16(o[2], o[3]); w.z = cvt_pk_bf16(o[4], o[5]); w.w = cvt_pk_bf16(o[6], o[7]);
                *(u32x4*)(H + tok * D + c0) = w; *(LAS u32x4*)(T + r * 4112 + (j * 64 + lane) * 16) = w;
                u32x2 w8; w8.x = pk4_fp8(o[0], o[1], o[2], o[3]); w8.y = pk4_fp8(o[4], o[5], o[6], o[7]); *(u32x2*)(H8 + tok * D + c0) = w8; } }
        __syncthreads();
        { f32x4 acc = (f32x4){0.f, 0.f, 0.f, 0.f};
#pragma unroll
          for (int kk = 0; kk < 8; ++kk) { const bf16x8 a = *(const LAS bf16x8*)(T + fr * 4112 + (256 * wave + 32 * kk + 8 * fq) * 2);
              acc = __builtin_amdgcn_mfma_f32_16x16x32_bf16(a, rwh[kk], acc, 0, 0, 0); acc = __builtin_amdgcn_mfma_f32_16x16x32_bf16(a, rwl[kk], acc, 0, 0, 0); }
#pragma unroll
          for (int j = 0; j < 4; ++j) PART[(wave * 16 + 4 * fq + j) * 16 + fr] = acc[j]; }
        __syncthreads();
        if (tid < 16) {
            const int r = tid; const int tok = grp * 16 + r; float lg[16]; float mx = -3.0e38f;
#pragma unroll
            for (int e4 = 0; e4 < 4; ++e4) { const f32x4 b4 = *(const f32x4*)(rb + 4 * e4); lg[4 * e4] = b4[0]; lg[4 * e4 + 1] = b4[1]; lg[4 * e4 + 2] = b4[2]; lg[4 * e4 + 3] = b4[3]; }
#pragma unroll 1
            for (int w = 0; w < 8; ++w) {
#pragma unroll
                for (int e4 = 0; e4 < 4; ++e4) { const f32x4 p4 = *(const LAS f32x4*)(PART + (w * 16 + r) * 16 + 4 * e4); lg[4 * e4] += p4[0]; lg[4 * e4 + 1] += p4[1]; lg[4 * e4 + 2] += p4[2]; lg[4 * e4 + 3] += p4[3]; } }
#pragma unroll
            for (int e = 0; e < 16; ++e) mx = fmaxf(mx, lg[e]);
#pragma unroll
            for (int e = 0; e < 16; ++e) lg[e] = __expf(lg[e] - mx);
            int bg = 0; float bscore = -1.f;
#pragma unroll
            for (int gq = 0; gq < 4; ++gq) { float a = -1.f, b = -1.f;
#pragma unroll
                for (int q = 0; q < 4; ++q) { const float p = lg[4 * gq + q]; if (p > a) { b = a; a = p; } else if (p > b) b = p; }
                const float sc = a + b; if (sc > bscore) { bscore = sc; bg = gq; } }
            int i0 = 0, i1 = 0; float p0 = -1.f, p1 = -1.f;
#pragma unroll
            for (int gq = 0; gq < 4; ++gq) if (gq == bg) {
#pragma unroll
                for (int q = 0; q < 4; ++q) { const float p = lg[4 * gq + q]; if (p > p0) { p1 = p0; i1 = i0; p0 = p; i0 = 4 * gq + q; } else if (p > p1) { p1 = p; i1 = 4 * gq + q; } } }
            const float inv = 1.0f / (p0 + p1);
            tokg[tok] = (f32x2){p0 * inv, p1 * inv};
            const int lt = it * 16 + r;
            TE[lt * 2] = i0; TE[lt * 2 + 1] = i1;
            TR[lt * 2] = atomicAdd((int*)&LCNT[i0], 1); TR[lt * 2 + 1] = atomicAdd((int*)&LCNT[i1], 1);
        }
        nloc = it * 16 + 16;
    }
    __syncthreads();
    if (tid < 16) LBASE[tid] = (int)__hip_atomic_fetch_add(gcnt + tid, (unsigned)LCNT[tid], __ATOMIC_RELAXED, __HIP_MEMORY_SCOPE_AGENT);
    __syncthreads();
    for (int lt = tid; lt < nloc; lt += NTHR) { const int it = lt >> 4, r = lt & 15; const int tok = (F.bx + it * F.G) * 16 + r;
        const int e0 = TE[lt * 2], e1 = TE[lt * 2 + 1]; const int s0 = LBASE[e0] + TR[lt * 2], s1 = LBASE[e1] + TR[lt * 2 + 1];
        rowlist[e0 * NTOK + s0] = tok; rowlist[e1 * NTOK + s1] = tok;
        toki[tok] = (i32x4){e0 | (e1 << 8), s0, s1, 0}; }
    __syncthreads();
}

__device__ __forceinline__ MoeTab moe_tables(Frame& F, int layer) {
    LAS int* M = (LAS int*)(F.lds + LDS_MOE);
    __syncthreads();
    if (F.tid == 0) { int tp = 0, sb = 0;
        for (int e = 0; e < 16; ++e) { const int c = (int)__hip_atomic_load(F.ctl + CW_CNT + 64 * layer + e, __ATOMIC_RELAXED, __HIP_MEMORY_SCOPE_AGENT); const int tl = (c + 255) >> 8;
            M[e] = tp; M[32 + e] = sb; M[64 + e] = c; tp += tl; sb += tl * 256; }
        M[16] = tp; }
    __syncthreads();
    MoeTab T; T.tp = M; T.sb = M + 32; T.cnt = M + 64; T.nU = __builtin_amdgcn_readfirstlane(M[16]) * 8; return T;
}

template <bool FINAL>
__device__ __forceinline__ void ln2_phase(Frame& F, const float* const* in, int layer, const MoeTab& T, float* out) {
    const bf16_t* H = (const bf16_t*)(F.ws + WS_D); const unsigned char* YB = F.ws + WS_B; bf16_t* H2 = (bf16_t*)(F.ws + WS_A);
    const float* lng = in[24] + layer * D; const float* lnb = in[25] + layer * D;
    const i32x4* toki = (const i32x4*)(F.ws + WS_TOKI); const f32x2* tokg = (const f32x2*)(F.ws + WS_TOKG);
    const int lane = F.lane;
    float gm[4][8], bt[4][8];
#pragma unroll
    for (int j = 0; j < 4; ++j) { const int c0 = (j * 64 + lane) * 8; const f32x4 g0 = *(const f32x4*)(lng + c0), g1 = *(const f32x4*)(lng + c0 + 4), b0 = *(const f32x4*)(lnb + c0), b1 = *(const f32x4*)(lnb + c0 + 4);
#pragma unroll
        for (int q = 0; q < 4; ++q) { gm[j][q] = g0[q]; gm[j][4 + q] = g1[q]; bt[j][q] = b0[q]; bt[j][4 + q] = b1[q]; } }
    const int gw = F.bx * NWAVES + F.wave, NGW = F.G * NWAVES;
    for (int tok = gw; tok < NTOK; tok += NGW) {
        const i32x4 ti = toki[tok]; const f32x2 tg = tokg[tok];
        const int e0 = ti.x & 255, e1 = (ti.x >> 8) & 255; const size_t p0 = (size_t)(T.sb[e0] + ti.y), p1 = (size_t)(T.sb[e1] + ti.z);
        float x[4][8]; float s = 0.f;
#pragma unroll
        for (int j = 0; j < 4; ++j) { const int c0 = (j * 64 + lane) * 8; const u32x4 h = *(const u32x4*)(H + (size_t)tok * D + c0); const u32x2 y0 = *(const u32x2*)(YB + p0 * D + c0), y1 = *(const u32x2*)(YB + p1 * D + c0);
            float a0[8], a1[8]; unpk4_fp8(y0.x, a0); unpk4_fp8(y0.y, a0 + 4); unpk4_fp8(y1.x, a1); unpk4_fp8(y1.y, a1 + 4);
            const float g0 = tg.x * (1.0f / SC_Y), g1 = tg.y * (1.0f / SC_Y);
#pragma unroll
            for (int q = 0; q < 4; ++q) { x[j][2 * q] = ALPHA * bf_lo(h[q]) + g0 * a0[2 * q] + g1 * a1[2 * q]; x[j][2 * q + 1] = ALPHA * bf_hi(h[q]) + g0 * a0[2 * q + 1] + g1 * a1[2 * q + 1]; s += x[j][2 * q] + x[j][2 * q + 1]; } }
        const float mu = wave_sum(s) * (1.0f / D); float s2 = 0.f;
#pragma unroll
        for (int j = 0; j < 4; ++j)
#pragma unroll
            for (int q = 0; q < 8; ++q) { x[j][q] -= mu; s2 += x[j][q] * x[j][q]; }
        const float rs = 1.0f / sqrtf(wave_sum(s2) * (1.0f / D) + LN_EPS);
#pragma unroll
        for (int j = 0; j < 4; ++j) { const int c0 = (j * 64 + lane) * 8; float o[8];
#pragma unroll
            for (int q = 0; q < 8; ++q) o[q] = x[j][q] * rs * gm[j][q] + bt[j][q];
            if constexpr (FINAL) { *(f32x4*)(out + (size_t)tok * D + c0) = (f32x4){o[0], o[1], o[2], o[3]}; *(f32x4*)(out + (size_t)tok * D + c0 + 4) = (f32x4){o[4], o[5], o[6], o[7]}; }
            else { u32x4 w; w.x = cvt_pk_bf16(o[0], o[1]); w.y = cvt_pk_bf16(o[2], o[3]); w.z = cvt_pk_bf16(o[4], o[5]); w.w = cvt_pk_bf16(o[6], o[7]); *(u32x4*)(H2 + (size_t)tok * D + c0) = w;
                u32x2 w8; w8.x = pk4_fp8(o[0], o[1], o[2], o[3]); w8.y = pk4_fp8(o[4], o[5], o[6], o[7]); *(u32x2*)(F.ws + WS_H8 + (size_t)tok * D + c0) = w8; } }
    }
}

__device__ __forceinline__ void scan_phase(Frame& F, const float* const* in) {
    const float* a_re = in[9]; const float* a_im = in[10]; const float* log_dt = in[11];
    const float* Xend = (const float*)(F.ws + WS_XEND); bf16_t* A2 = (bf16_t*)(F.ws + WS_A2);
    for (int idx = F.bx * NTHR + F.tid; idx < BG * NBATCH * BST; idx += F.G * NTHR) {
        const int p = idx & 63, b = (idx >> 6) & 15, g = idx >> 10;
        const float dt = expf(log_dt[g]); const float zr = a_re[g * 64 + p] * dt * 16.0f, zi = a_im[g * 64 + p] * dt * 16.0f;
        const float mag = expf(zr); float sn, cs; sincosf(zi, &sn, &cs); const float ar = mag * cs, ai = mag * sn;
        float xr = 0.f, xi = 0.f; const size_t row0 = (size_t)g * 2048 + b * 128;
#pragma unroll 8
        for (int j = 0; j < 128; ++j) { const size_t row = row0 + j; const float er = Xend[row * 128 + p], ei = Xend[row * 128 + 64 + p];
            A2[row * 384 + 256 + p] = (bf16_t)f2bf(xr); A2[row * 384 + 320 + p] = (bf16_t)f2bf(xi);
            const float nr = ar * xr - ai * xi + er, ni = ar * xi + ai * xr + ei; xr = nr; xi = ni; }
    }
}

__device__ __forceinline__ void convert_experts(Frame& F, const float* const* in, int layer) {
    int itbase = 0; __syncthreads();
    transpose_job_f8(F, in[22] + (size_t)layer * 16 * 2048 * 2048, F.ws + (layer == 0 ? WS_EIN : WS_EIN1), 16, 2048, 2048, true, SC_WIN, itbase);
    transpose_job_f8(F, in[23] + (size_t)layer * 16 * 1024 * 2048, F.ws + (layer == 0 ? WS_EOUT : WS_EOUT1), 16, 1024, 2048, false, SC_WOUT, itbase);
    __syncthreads();
}
#ifndef PHASE_MASK
#define PHASE_MASK 0x1ffff
#endif
template <int LAYER>
__device__ __forceinline__ void moe_block(Frame& F, const Args& args, const XcdBarrier& bar) {
    const int lo = args.ph_lo, hi = args.ph_hi; const float* const* in = args.in; unsigned char* ws = args.ws;
    constexpr int pb = LAYER == 0 ? 4 : 13;
#define IN(k) (((PHASE_MASK >> (k)) & 1) && lo <= (k) && (k) < hi)
#define SEAM(k) do { if (IN(k) && IN((k) + 1)) xcd_barrier(bar); } while (0)
    if (IN(pb)) { ln_route_phase(F, in, LAYER); } SEAM(pb);
    if (IN(pb + 1)) { MoeTab T = moe_tables(F, LAYER);
        GemmM1 g; g.nostore = args.flags & 1; g.init_bytes(2048, 2048, F.G, F.bx); g.H8 = ws + WS_H8; g.Bt = ws + (LAYER == 0 ? WS_EIN : WS_EIN1); g.ACT = ws + WS_A; g.T = T;
        LAS int* rows = (LAS int*)(F.lds + LDS_ROWS); g.rows = rows;
        const int* rowlist = (const int*)(ws + WS_ROWLIST);
        { pg8::Unit u; for (int ui = 0; ui < 10 && g.next(ui, u); ++ui) { if (F.tid < 256) { const int slot = u.w * 256 + F.tid; rows[ui * 256 + F.tid] = (slot < __builtin_amdgcn_readfirstlane(T.cnt[u.z])) ? rowlist[u.z * NTOK + slot] : 0; } } }
        __syncthreads();
        if constexpr (LAYER == 0) { if (F.bx & 1) convert_experts(F, in, 1); }
        pg8::gemm_phase(F.lds, g);
        if constexpr (LAYER == 0) { if (!(F.bx & 1)) convert_experts(F, in, 1); } } SEAM(pb + 1);
    if (IN(pb + 2)) { MoeTab T = moe_tables(F, LAYER);
        GemmM2 g; g.nostore = args.flags & 1; g.init_bytes(1024, 1024, F.G, F.bx); g.ACT = ws + WS_A; g.Bt = ws + (LAYER == 0 ? WS_EOUT : WS_EOUT1); g.YB = ws + WS_B; g.T = T; g.hstepB = (size_t)8 * g.ldb2;
        pg8::gemm_phase(F.lds, g); } SEAM(pb + 2);
    if (IN(pb + 3)) { MoeTab T = moe_tables(F, LAYER);
        if constexpr (LAYER == 0) { ln2_phase<false>(F, in, 0, T, nullptr); }
        else ln2_phase<true>(F, in, 1, T, args.out); }
#undef IN
#undef SEAM
}

constexpr int N_PHASES = 17;
__global__ void __launch_bounds__(NTHR, 2) fwd_kernel(Args args) {
    extern __shared__ __attribute__((aligned(16))) unsigned char lds_raw[];
    Frame F; F.lds = (LAS unsigned char*)lds_raw; F.ws = args.ws; F.ctl = (unsigned*)(args.ws + WS_CTL);
    F.tid = threadIdx.x; F.lane = F.tid & 63; F.wave = __builtin_amdgcn_readfirstlane(F.tid >> 6); F.G = gridDim.x; F.bx = blockIdx.x;
    if (F.tid < 4) ((LAS unsigned*)(F.lds + LDS_BARW))[F.tid] = 0u;
    __syncthreads();
    XcdBarrier bar; bar.bar = F.ctl + CW_BAR; bar.x = 0; bar.st = nullptr;
    const bool one = (args.ph_hi - args.ph_lo) > 1;
    if (one) bar = xcd_barrier_post(F.ctl + CW_BAR, (volatile LAS unsigned*)(F.lds + LDS_BARW));
    const int lo = args.ph_lo, hi = args.ph_hi;
#ifndef PHASE_MASK
#define PHASE_MASK 0x1ffff
#endif
#define IN(k) (((PHASE_MASK >> (k)) & 1) && lo <= (k) && (k) < hi)
#define SEAM(k) do { if (IN(k) && IN((k) + 1)) xcd_barrier(bar); } while (0)
    const float* const* in = args.in;
    unsigned char* ws = args.ws;

    if (IN(0)) { p0_prologue(F, in); } SEAM(0);
    if (IN(1)) { GemmG1 g; g.nostore = args.flags & 1; g.init_bytes(2048, 2048, F.G, F.bx); g.A = ws + WS_X8; g.Bt = ws + WS_WIN; g.O = ws + WS_B; g.bias = in[2]; g.hstepB = (size_t)8 * g.ldb2;
        if (F.bx & 1) convert_experts(F, in, 0);
        pg8::gemm_phase(F.lds, g);
        if (!(F.bx & 1)) convert_experts(F, in, 0); } SEAM(1);
    if (IN(2)) { g2_phase(F, in); } SEAM(2);
    if (IN(3)) { GemmG3 g; g.nostore = args.flags & 1; g.init_bytes(2048, 2048, F.G, F.bx); g.A = ws + WS_H8; g.Bt = ws + WS_WOUT; g.Z = (bf16_t*)(ws + WS_C); g.R = (const bf16_t*)(ws + WS_A); g.hstepB = (size_t)8 * g.ldb2;
        pg8::gemm_phase(F.lds, g); } SEAM(3);
    moe_block<0>(F, args, bar);
    SEAM(7);
    if (IN(8)) { GemmS1 g; g.nostore = args.flags & 1; g.init_bytes(2048, 2048, F.G, F.bx); g.A = ws + WS_H8; g.Bt = ws + WS_BWIN; g.A2 = (bf16_t*)(ws + WS_A2); g.hstepB = (size_t)8 * g.ldb2;
        pg8::gemm_phase(F.lds, g); } SEAM(8);
    if (IN(9)) { GemmS2 g; g.nostore = args.flags & 1; g.init_plain(256, 384, F.G, F.bx); g.A2 = (const bf16_t*)(ws + WS_A2); g.Et = (const bf16_t*)(ws + WS_SSME); g.Xend = (float*)(ws + WS_XEND);
        pg8::gemm_phase(F.lds, g); } SEAM(9);
    if (IN(10)) { scan_phase(F, in); } SEAM(10);
    if (IN(11)) { GemmS4 g; g.nostore = args.flags & 1; g.init_plain(384, 384, F.G, F.bx); g.A2 = (const bf16_t*)(ws + WS_A2); g.Bs = (const bf16_t*)(ws + WS_SSMB); g.Y = ws + WS_Y; g.hstepB = (size_t)8 * g.ldb2;
        pg8::gemm_phase(F.lds, g); } SEAM(11);
    if (IN(12)) { GemmS5 g; g.nostore = args.flags & 1; g.init_bytes(1024, 0, F.G, F.bx); g.kstepA = 8u * 2048u * 256u; g.Y = ws + WS_Y; g.Bt = ws + WS_BWOUT; g.Z = (bf16_t*)(ws + WS_C); g.R = (const bf16_t*)(ws + WS_A);
        pg8::gemm_phase(F.lds, g); } SEAM(12);
    moe_block<1>(F, args, bar);
#undef IN
#undef SEAM
}

extern "C" void kernel_launch(void* const* d_in, const int* in_sizes, int n_in, void* d_out, int out_size, void* d_ws, size_t ws_size, hipStream_t stream) {
    static int grid = 0;
    if (grid == 0) {
        if (n_in != 26 || in_sizes[0] != NTOK * D || out_size != NTOK * D || ws_size < WS_END) { fprintf(stderr, "kernel_launch: unexpected problem (n_in %d, ws %zu)\n", n_in, ws_size); grid = -1; return; }
        int dev = 0, cus = 0, per_cu = 0;
        if (hipGetDevice(&dev) != hipSuccess || hipDeviceGetAttribute(&cus, hipDeviceAttributeMultiprocessorCount, dev) != hipSuccess) { grid = -1; return; }
        if (hipFuncSetAttribute((const void*)fwd_kernel, hipFuncAttributeMaxDynamicSharedMemorySize, LDS_BYTES) != hipSuccess) { fprintf(stderr, "kernel_launch: hipFuncSetAttribute failed\n"); grid = -1; return; }
        if (hipOccupancyMaxActiveBlocksPerMultiprocessor(&per_cu, (const void*)fwd_kernel, NTHR, LDS_BYTES) != hipSuccess || per_cu < 1) fprintf(stderr, "kernel_launch: occupancy query reports %d\n", per_cu);
        (void)hipGetLastError();
        grid = cus;
        if (grid != 256) fprintf(stderr, "kernel_launch: %d CUs (built for 256)\n", grid);
    }
    if (grid < 0) return;
    if (hipMemsetAsync((char*)d_ws + WS_CTL, 0, CTL_ZERO_BYTES, stream) != hipSuccess) return;
    Args a{};
    for (int i = 0; i < 26; ++i) a.in[i] = (const float*)d_in[i];
    a.out = (float*)d_out; a.ws = (unsigned char*)d_ws;
#if MK_N_LAUNCHES == 1
    a.ph_lo = 0; a.ph_hi = N_PHASES;
    hipLaunchKernelGGL(fwd_kernel, dim3(grid), dim3(NTHR), LDS_BYTES, stream, a);
#else
    for (int p = 0; p < N_PHASES; ++p) { a.ph_lo = p; a.ph_hi = p + 1; for (int r = 0; r < 1 + ((REPEAT_MASK >> p) & 1); ++r) { a.flags = (PROBE_NOSTORE && r == 0 && ((REPEAT_MASK >> p) & 1)) ? 1 : 0; hipLaunchKernelGGL(fwd_kernel, dim3(grid), dim3(NTHR), LDS_BYTES, stream, a); } }
#endif
}
```

```cpp
#include <hip/hip_runtime.h>
#include <cstdio>
#include <cstdint>

#ifndef PROBE_NOSTORE
#define PROBE_NOSTORE 0
#endif
#ifndef REPEAT_MASK
#define REPEAT_MASK 0x0
#endif
#ifndef MK_N_LAUNCHES
#define MK_N_LAUNCHES 1
#endif

#define GAS __attribute__((address_space(1)))
#define LAS __attribute__((address_space(3)))
typedef unsigned short bf16_t;
typedef short bf16x8 __attribute__((ext_vector_type(8)));
typedef float f32x4 __attribute__((ext_vector_type(4)));
typedef float f32x2 __attribute__((ext_vector_type(2)));
typedef unsigned u32x4 __attribute__((ext_vector_type(4)));
typedef unsigned u32x2 __attribute__((ext_vector_type(2)));
typedef int i32x4 __attribute__((ext_vector_type(4)));
typedef int i32x8 __attribute__((ext_vector_type(8)));

constexpr int D = 2048, NTOK = 32768, SEQ = 2048, NBATCH = 16;
constexpr int CHUNK = 128, AG = 8, AGD = 256;
constexpr int BW = 1024, BG = 64, BCH = 16, BST = 64;
constexpr int NE = 16, DFF = 1024;
constexpr float ALPHA = 1.41421356237f, LN_EPS = 1e-5f;
constexpr int NWAVES = 8, NTHR = 512;

constexpr size_t MiB = 1u << 20;
constexpr size_t WS_CTL = 0, CTL_ZERO_BYTES = 1 * MiB;
constexpr size_t WS_ROWLIST = 1 * MiB;
constexpr size_t WS_TOKI = 3 * MiB;
constexpr size_t WS_TOKG = 3 * MiB + 512 * 1024;
constexpr size_t WS_WTRIL = 3 * MiB + 768 * 1024;
constexpr size_t WS_SSMB = 4 * MiB;
constexpr size_t WS_SSME = 16 * MiB;
constexpr size_t WS_RWF = 24 * MiB;
constexpr size_t WS_WIN = 32 * MiB;
constexpr size_t WS_WOUT = 48 * MiB;
constexpr size_t WS_BWIN = 56 * MiB;
constexpr size_t WS_BWOUT = 60 * MiB;
constexpr size_t WS_EIN = 72 * MiB;
constexpr size_t WS_H8 = 136 * MiB;
constexpr size_t WS_EOUT = 200 * MiB;
constexpr size_t WS_A = 264 * MiB;
constexpr size_t WS_B = 408 * MiB;
constexpr size_t WS_C = 664 * MiB;
constexpr size_t WS_D = 792 * MiB;
constexpr size_t WS_EIN1 = 920 * MiB;
constexpr size_t WS_EOUT1 = 984 * MiB;
constexpr size_t WS_END = 1016 * MiB;
constexpr size_t WS_X8 = WS_D;
constexpr size_t WS_A2 = WS_B, WS_XEND = WS_B + 96 * MiB, WS_Y = WS_B + 160 * MiB;
constexpr int ACT_ROWS = 65536 + 16 * 256;
constexpr int CW_BAR = 4096;
constexpr int CW_XQ = 16384 + 1024;
constexpr int CW_CNT = 16384;

constexpr int RING_BYTES = 131072;
constexpr int LDS_ROWS = RING_BYTES;
constexpr int LDS_MOE = LDS_ROWS + 10 * 1024;
constexpr int LDS_BARW = LDS_MOE + 512;
constexpr int LDS_BYTES = 147456;

__device__ __forceinline__ unsigned cvt_pk_bf16(float lo, float hi) { unsigned r; asm("v_cvt_pk_bf16_f32 %0, %1, %2" : "=v"(r) : "v"(lo), "v"(hi)); return r; }
__device__ __forceinline__ float bf_lo(unsigned w) { return __uint_as_float(w << 16); }
__device__ __forceinline__ float bf_hi(unsigned w) { return __uint_as_float(w & 0xffff0000u); }
__device__ __forceinline__ unsigned f2bf(float f) { unsigned u = __float_as_uint(f); return (u + 0x7fffu + ((u >> 16) & 1u)) >> 16; }
__device__ __forceinline__ float wave_sum(float v) {
#pragma unroll
    for (int o = 1; o < 64; o <<= 1) v += __shfl_xor(v, o);
    return v;
}
__device__ __forceinline__ f32x2 gelu2(f32x2 x) {
    f32x2 xc; xc.x = __builtin_amdgcn_fmed3f(x.x, -3.5f, 3.5f); xc.y = __builtin_amdgcn_fmed3f(x.y, -3.5f, 3.5f);
    const f32x2 u = xc * xc;
    f32x2 p = u * (-8.701348406248144e-07f) + 4.0298804378835484e-05f; p = p * u + (-0.0007917149341665208f); p = p * u + 0.00885754730552435f; p = p * u + (-0.06504099816083908f); p = p * u + 0.3982582986354828f;
    return x * (xc * p + 0.5f);
}
__device__ __forceinline__ f32x2 gelu2x8(f32x2 x) {
    f32x2 xc; xc.x = __builtin_amdgcn_fmed3f(x.x, -3.5f, 3.5f); xc.y = __builtin_amdgcn_fmed3f(x.y, -3.5f, 3.5f);
    const f32x2 u = xc * xc;
    f32x2 p = u * (8.0f * -8.701348406248144e-07f) + (8.0f * 4.0298804378835484e-05f); p = p * u + (8.0f * -0.0007917149341665208f); p = p * u + (8.0f * 0.00885754730552435f); p = p * u + (8.0f * -0.06504099816083908f); p = p * u + (8.0f * 0.3982582986354828f);
    return x * (xc * p + 4.0f);
}
__device__ __forceinline__ f32x2 sig2(f32x2 g) {
    f32x2 gc; gc.x = __builtin_amdgcn_fmed3f(g.x, -7.0f, 7.0f); gc.y = __builtin_amdgcn_fmed3f(g.y, -7.0f, 7.0f);
    const f32x2 u = gc * gc;
    f32x2 p = u * 9.362564196147005e-11f + (-1.7167415933272423e-08f); p = p * u + 1.283512915506435e-06f; p = p * u + (-5.098102701595053e-05f); p = p * u + 0.0011952189961448312f; p = p * u + (-0.01824037730693817f); p = p * u + 0.247629314661026f;
    return gc * p + 0.5f;
}
__device__ __forceinline__ unsigned pk2(f32x2 v) { return cvt_pk_bf16(v.x, v.y); }
__device__ __forceinline__ unsigned pk4_fp8(float a, float b, float c, float d) {
    int w = 0;
    w = __builtin_amdgcn_cvt_pk_fp8_f32(__builtin_amdgcn_fmed3f(a, -448.f, 448.f), __builtin_amdgcn_fmed3f(b, -448.f, 448.f), w, false);
    w = __builtin_amdgcn_cvt_pk_fp8_f32(__builtin_amdgcn_fmed3f(c, -448.f, 448.f), __builtin_amdgcn_fmed3f(d, -448.f, 448.f), w, true);
    return (unsigned)w;
}
__device__ __forceinline__ void unpk4_fp8(unsigned w, float* o) { const f32x2 a = __builtin_amdgcn_cvt_pk_f32_fp8((int)w, false), b = __builtin_amdgcn_cvt_pk_f32_fp8((int)w, true); o[0] = a.x; o[1] = a.y; o[2] = b.x; o[3] = b.y; }
__device__ __forceinline__ unsigned pk4_fp8_nc(float a, float b, float c, float d) { int w = 0; w = __builtin_amdgcn_cvt_pk_fp8_f32(a, b, w, false); w = __builtin_amdgcn_cvt_pk_fp8_f32(c, d, w, true); return (unsigned)w; }
constexpr float SC_WIN = 32.0f, SC_WOUT = 64.0f, SC_ACT = 8.0f, SC_Y = 16.0f, SC_BW = 32.0f, SC_YS = 8.0f, SC_AWO = 64.0f, SC_P = 4.0f, SC_AWI = 32.0f, SC_UV = 8.0f, SC_Z = 16.0f;
#define LO2(v) ((f32x2){(v)[0], (v)[1]})
#define HI2(v) ((f32x2){(v)[2], (v)[3]})

#define XB_TMO      128
#define XB_XCNT(j)  (256  + 64 * (j))
#define XB_XSUB(j)  (1280 + 64 * (j))
#define XB_XGEN(j)  (2304 + 64 * (j))
#define XB_TOP      3328
#define XB_TOPGEN   3392
#define XCD_BAR_WORDS 3456
#define XB_SPIN_CAP (1u << 18)
__device__ __forceinline__ unsigned xb_ld(unsigned* p)              { return __hip_atomic_load(p, __ATOMIC_RELAXED, __HIP_MEMORY_SCOPE_AGENT); }
__device__ __forceinline__ unsigned xb_add(unsigned* p, unsigned v) { return __hip_atomic_fetch_add(p, v, __ATOMIC_RELAXED, __HIP_MEMORY_SCOPE_AGENT); }
__device__ __forceinline__ unsigned xb_xcc_id() { return (unsigned)__builtin_amdgcn_s_getreg((3 << 11) | 20) & 0xFu; }
#define XB_SPIN(cond, bar) do { unsigned _sp = 0; while (cond) { __builtin_amdgcn_s_sleep(1); \
    if ((++_sp & 255u) == 0u) { if (xb_ld(&(bar)[XB_TMO])) break; if (_sp > XB_SPIN_CAP) { atomicAdd(&(bar)[XB_TMO], 1u); break; } } } } while (0)
struct XcdBarrier { unsigned* bar; unsigned x; volatile LAS unsigned* st; };
__device__ __forceinline__ XcdBarrier xcd_barrier_post(unsigned* bar, volatile LAS unsigned* st) {
    XcdBarrier b; b.bar = bar; b.x = xb_xcc_id(); b.st = st;
    if (threadIdx.x == 0) (void)xb_add(&bar[XB_XCNT(b.x)], 1u);
    return b;
}
__device__ __forceinline__ void xcd_barrier_complete(unsigned* bar, unsigned x, unsigned& nloc, unsigned& nx) {
    const unsigned G = gridDim.x * gridDim.y * gridDim.z;
    unsigned sum, cnt, mine, sp = 0u;
    for (;;) {
        sum = 0u; cnt = 0u; mine = 0u;
#pragma unroll
        for (unsigned j = 0; j < 16; ++j) { const unsigned c = xb_ld(&bar[XB_XCNT(j)]); sum += c; cnt += (c > 0u) ? 1u : 0u; mine = (j == x) ? c : mine; }
        if (sum == G) break;
        __builtin_amdgcn_s_sleep(1);
        if ((++sp & 255u) == 0u) { if (xb_ld(&bar[XB_TMO])) break; if (sp > XB_SPIN_CAP) { atomicAdd(&bar[XB_TMO], 1u); break; } }
    }
    nloc = mine > 0u ? mine : 1u; nx = cnt > 0u ? cnt : 1u;
}
__device__ __forceinline__ void xcd_barrier(const XcdBarrier& b) {
    asm volatile("s_waitcnt vmcnt(0)" ::: "memory");
    __syncthreads();
    if (threadIdx.x == 0) {
        unsigned* bar = b.bar;
        __builtin_amdgcn_s_waitcnt(0);
        unsigned nloc = b.st[0], nx = b.st[1];
        if (nloc == 0u) { xcd_barrier_complete(bar, b.x, nloc, nx); b.st[0] = nloc; b.st[1] = nx; }
        const unsigned old = xb_add(&bar[XB_XSUB(b.x)], 1u);
        const unsigned gen = old / nloc;
        if (old + 1u == (gen + 1u) * nloc) {
            __builtin_amdgcn_fence(__ATOMIC_RELEASE, "agent");
            asm volatile("s_waitcnt vmcnt(0)" ::: "memory");
            const unsigned og = xb_add(&bar[XB_TOP], 1u);
            const unsigned tg = og / nx;
            if (og + 1u == (tg + 1u) * nx) xb_add(&bar[XB_TOPGEN], 1u);
            else XB_SPIN(xb_ld(&bar[XB_TOPGEN]) == tg, bar);
            __builtin_amdgcn_fence(__ATOMIC_ACQUIRE, "agent");
            xb_add(&bar[XB_XGEN(b.x)], 1u);
            asm volatile("s_waitcnt vmcnt(0)" ::: "memory");
        } else {
            XB_SPIN(xb_ld(&bar[XB_XGEN(b.x)]) == gen, bar);
            __builtin_amdgcn_fence(__ATOMIC_ACQUIRE, "agent");
            asm volatile("s_waitcnt vmcnt(0)" ::: "memory");
        }
    }
    __syncthreads();
}

namespace pg8 {
constexpr int BM = 256, BK = 64, HALF = 128, HTB = HALF * BK * 2, STAGE_BYTES = 8 * HTB, NXCD = 8, WGM = 8;
__device__ __forceinline__ int lds_byte(int r, int c) { const int st = (r >> 4) * 2 + (c >> 5), rr = r & 15, cc = c & 31, ob = rr * 64 + cc * 2; return st * 1024 + (ob ^ (((ob >> 9) & 1) << 5)); }
__device__ __forceinline__ void stage_rc(int b, int& R, int& C) { const int st = b / 1024, sb = b % 1024, swz = sb ^ (((sb >> 9) & 1) << 5); R = (st >> 1) * 16 + swz / 64; C = (st & 1) * 32 + (swz % 64) / 2; }
__device__ __forceinline__ int perm32(int rho) { const int n = rho >> 4, i = rho & 15; return 8 * (i >> 2) + 4 * n + (i & 3); }

struct Unit { const char* a; const char* b; int x, y, z, w; };
typedef f32x4 Acc[2][2][4][2];

__device__ __forceinline__ bool static_unit(long L, int nM, int nN, int& pm, int& pn) {
    const int nwg = nM * nN; if (L >= nwg) return false;
    int wgid = (int)L; { const int q = nwg / NXCD, r = nwg % NXCD, xcd = wgid % NXCD, off = wgid / NXCD; wgid = (xcd < r ? xcd * (q + 1) : r * (q + 1) + (xcd - r) * q) + off; }
    const int nig = WGM * nN, gid = wgid / nig, fm = gid * WGM, gsz = (nM - fm) < WGM ? (nM - fm) : WGM;
    pm = fm + ((wgid % nig) % gsz); pn = (wgid % nig) / gsz; return true;
}

template <class G>
__device__ __forceinline__ void gemm_phase(LAS unsigned char* lds, const G& g) {
    const int tid = threadIdx.x, wid = __builtin_amdgcn_readfirstlane(tid >> 6), lane = tid & 63, wr = wid >> 2, wc = wid & 3, fr = lane & 15, fq = lane >> 4;
    const int nt = g.nt;
    unsigned voffB[2], vA0[2], vA1[2], nA0[2], nA1[2]; int Rl[2], Cl[2];
#pragma unroll
    for (int i = 0; i < 2; ++i) { int R, C; stage_rc(tid * 16 + i * 8192, R, C); const int Rb = (G::PERMK == 2) ? (64 * (R >> 5) + 16 * ((R & 15) >> 2) + 4 * ((R >> 4) & 1) + (R & 3)) : (G::PERMK == 1) ? ((R & ~31) + perm32(R & 31)) : R;
        Rl[i] = R; Cl[i] = C; voffB[i] = g.voffB(Rb, C); }
    const size_t kstepA = g.kstepA, kstepB = g.kstepB, hstepB = g.hstepB;
    const unsigned ldsw = (unsigned)wid * 1024u;
    const int aoff = lds_byte(wr * 64 + fr, fq * 8), boff = lds_byte(wc * 32 + fr, fq * 8);
#define PG8_SA(b, h) (((b) * 2 + (h)) * HTB)
#define PG8_SB(b, h) ((4 + (b) * 2 + (h)) * HTB)
#define PG8_STAGE(bufoff, gbase, voff) do { _Pragma("unroll") for (int _i = 0; _i < 2; ++_i) \
        __builtin_amdgcn_global_load_lds((const unsigned*)((const char*)(gbase) + (voff)[_i]), (LAS unsigned*)(lds + (bufoff) + ldsw + _i * 8192), 16, 0, 0); } while (0)
#define PG8_LDA(dst, b, h) do { _Pragma("unroll") for (int m = 0; m < 4; ++m) _Pragma("unroll") for (int k = 0; k < 2; ++k) dst[m][k] = *(const LAS i32x4*)(lds + PG8_SA(b, h) + aoff + m * 2048 + k * 1024); } while (0)
#define PG8_LDB(dst, b, h) do { _Pragma("unroll") for (int n = 0; n < 2; ++n) _Pragma("unroll") for (int k = 0; k < 2; ++k) dst[n][k] = *(const LAS i32x4*)(lds + PG8_SB(b, h) + boff + n * 2048 + k * 1024); } while (0)
#define PG8_CAT(f) __builtin_shufflevector((f)[0], (f)[1], 0, 1, 2, 3, 4, 5, 6, 7)
#define PG8_MMA(ai, bj, At, Bt) do { __builtin_amdgcn_s_setprio(1); \
        if constexpr (G::FP8) { _Pragma("unroll") for (int m = 0; m < 4; ++m) _Pragma("unroll") for (int n = 0; n < 2; ++n) \
            asm volatile("v_mfma_scale_f32_16x16x128_f8f6f4 %0, %1, %2, %0, %3, %3 op_sel_hi:[0,0,0]" : "+v"(acc[ai][bj][m][n]) : "v"(PG8_CAT(Bt[n])), "v"(PG8_CAT(At[m])), "v"(sc1)); } \
        else { _Pragma("unroll") for (int m = 0; m < 4; ++m) _Pragma("unroll") for (int n = 0; n < 2; ++n) _Pragma("unroll") for (int k = 0; k < 2; ++k) \
            acc[ai][bj][m][n] = __builtin_amdgcn_mfma_f32_16x16x32_bf16(__builtin_bit_cast(bf16x8, Bt[n][k]), __builtin_bit_cast(bf16x8, At[m][k]), acc[ai][bj][m][n], 0, 0, 0); } \
        __builtin_amdgcn_s_setprio(0); } while (0)
#define PG8_ZERO(ai) do { _Pragma("unroll") for (int b = 0; b < 2; ++b) _Pragma("unroll") for (int m = 0; m < 4; ++m) _Pragma("unroll") for (int n = 0; n < 2; ++n) acc[ai][b][m][n] = (f32x4){0.f, 0.f, 0.f, 0.f}; } while (0)
#define PG8_WAIT_V(n) asm volatile("s_waitcnt vmcnt(" #n ")" ::: "memory")
#define PG8_WAIT_L(n) asm volatile("s_waitcnt lgkmcnt(" #n ")" ::: "memory")
#define PG8_BAR __builtin_amdgcn_s_barrier()
#define PG8_SCHED __builtin_amdgcn_sched_barrier(0)
    Unit cur, nxt; int ui = 0;
    if (!g.next(0, cur)) return;
    Acc acc;
#pragma unroll
    for (int a = 0; a < 2; ++a)
#pragma unroll
        for (int b = 0; b < 2; ++b)
#pragma unroll
            for (int m = 0; m < 4; ++m)
#pragma unroll
                for (int n = 0; n < 2; ++n) acc[a][b][m][n] = (f32x4){0.f, 0.f, 0.f, 0.f};
    i32x4 At[4][2], B0[2][2], B1[2][2];
    const int sc1 = 0x7f7f7f7f;
    const char* cA = cur.a; const char* cB = cur.b;
#pragma unroll
    for (int i = 0; i < 2; ++i) {
        if constexpr (G::GATHER) { vA0[i] = g.gatherA(0, Rl[i], Cl[i], 0); vA1[i] = g.gatherA(0, Rl[i], Cl[i], 1); }
        else { vA0[i] = g.voffA(Rl[i], Cl[i], 0); vA1[i] = g.voffA(Rl[i], Cl[i], 1); }
        nA0[i] = vA0[i]; nA1[i] = vA1[i];
    }
    PG8_STAGE(PG8_SB(0, 0), cB, voffB); PG8_STAGE(PG8_SB(0, 1), cB + hstepB, voffB); PG8_STAGE(PG8_SA(0, 0), cA, vA0); PG8_STAGE(PG8_SA(0, 1), cA, vA1);
    if (wr == 1) PG8_BAR;
    PG8_WAIT_V(2); PG8_BAR;
    PG8_STAGE(PG8_SB(1, 0), cB + kstepB, voffB); PG8_STAGE(PG8_SA(1, 0), cA + kstepA, vA0); PG8_STAGE(PG8_SB(1, 1), cB + hstepB + kstepB, voffB);
    PG8_WAIT_V(6); PG8_BAR;
    for (;;) {
        const bool has_next = g.next(ui + 1, nxt);
        const char* nA = has_next ? nxt.a : cA; const char* nB = has_next ? nxt.b : cB;
        for (int t = 0; t < nt; t += 2) {
            const bool last = (t == nt - 2);
            const char* a1 = cA + (size_t)(t + 1) * kstepA;
            const char* a2 = last ? nA : cA + (size_t)(t + 2) * kstepA; const char* b2 = last ? nB : cB + (size_t)(t + 2) * kstepB;
            const char* a3 = a2 + kstepA; const char* b3 = b2 + kstepB;
            unsigned s0[2], s1[2];
            if constexpr (G::GATHER) {
                if (last && has_next) {
#pragma unroll
                    for (int i = 0; i < 2; ++i) { nA0[i] = g.gatherA(ui + 1, Rl[i], Cl[i], 0); nA1[i] = g.gatherA(ui + 1, Rl[i], Cl[i], 1); }
                }
#pragma unroll
                for (int i = 0; i < 2; ++i) { s0[i] = last ? nA0[i] : vA0[i]; s1[i] = last ? nA1[i] : vA1[i]; }
            } else {
#pragma unroll
                for (int i = 0; i < 2; ++i) { s0[i] = vA0[i]; s1[i] = vA1[i]; }
            }
            PG8_LDB(B0, 0, 0); PG8_LDB(B1, 0, 1); PG8_SCHED; PG8_LDA(At, 0, 0); PG8_STAGE(PG8_SA(1, 1), a1, vA1);
            if constexpr (G::FP8) if (t == 0) PG8_ZERO(0);
            PG8_WAIT_V(8); PG8_WAIT_L(0); PG8_BAR; PG8_MMA(0, 0, At, B0); PG8_MMA(0, 1, At, B1); PG8_BAR; PG8_SCHED;
            PG8_LDA(At, 0, 1); PG8_STAGE(PG8_SB(0, 0), b2, voffB); PG8_STAGE(PG8_SB(0, 1), b2 + hstepB, voffB); PG8_STAGE(PG8_SA(0, 0), a2, s0);
            if constexpr (G::FP8) if (t == 0) PG8_ZERO(1);
            PG8_WAIT_V(8); PG8_WAIT_L(0); PG8_BAR; PG8_MMA(1, 0, At, B0); PG8_MMA(1, 1, At, B1); PG8_BAR; PG8_SCHED;
            PG8_LDB(B0, 1, 0); PG8_LDB(B1, 1, 1); PG8_SCHED; PG8_LDA(At, 1, 0); PG8_STAGE(PG8_SA(0, 1), a2, s1);
            PG8_WAIT_V(8); PG8_WAIT_L(0); PG8_BAR; PG8_MMA(0, 0, At, B0); PG8_MMA(0, 1, At, B1); PG8_BAR; PG8_SCHED;
            PG8_LDA(At, 1, 1); PG8_STAGE(PG8_SB(1, 0), b3, voffB); PG8_STAGE(PG8_SB(1, 1), b3 + hstepB, voffB); PG8_STAGE(PG8_SA(1, 0), a3, s0);
            PG8_WAIT_V(8); PG8_WAIT_L(0); PG8_BAR; PG8_MMA(1, 0, At, B0); PG8_MMA(1, 1, At, B1); PG8_BAR; PG8_SCHED;
        }
        if (wr == 0) PG8_BAR;
        if constexpr (G::FP8) asm volatile("s_nop 15\n\ts_nop 15\n\ts_nop 15" ::: "memory");
        if (!g.nostore) g.epi(acc, cur, wr, wc, fr, fq);
        if (!has_next) break;
        if constexpr (!G::FP8) { PG8_ZERO(0); PG8_ZERO(1); }
        cur = nxt; cA = nA; cB = nB; ++ui;
#pragma unroll
        for (int i = 0; i < 2; ++i) { vA0[i] = nA0[i]; vA1[i] = nA1[i]; }
        if (wr == 1) PG8_BAR;
    }
    PG8_WAIT_V(0);
    PG8_BAR;
#undef PG8_SA
#undef PG8_SB
#undef PG8_STAGE
#undef PG8_LDA
#undef PG8_LDB
#undef PG8_MMA
#undef PG8_CAT
#undef PG8_ZERO
#undef PG8_WAIT_V
#undef PG8_WAIT_L
#undef PG8_BAR
#undef PG8_SCHED
}
}

struct GemmBase {
    static constexpr bool GATHER = false, FP8 = false; static constexpr int PERMK = 1;
    int nt; unsigned kstepA, kstepB; size_t hstepB; int G, c; int nostore = 0;
    unsigned lda2, hstepA, ldb2;
    __device__ __forceinline__ unsigned voffA(int R, int C, int h) const { return (unsigned)R * lda2 + (unsigned)C * 2u + (unsigned)h * hstepA; }
    __device__ __forceinline__ unsigned voffB(int Rb, int C) const { return (unsigned)Rb * ldb2 + (unsigned)C * 2u; }
    __device__ __forceinline__ unsigned gatherA(int, int, int, int) const { return 0u; }
    __device__ __forceinline__ void init_bytes(int Kbytes, int lda_bytes, int G_, int c_) {
        nt = Kbytes / 128; kstepA = 128u; kstepB = 128u; ldb2 = (unsigned)Kbytes; hstepB = (size_t)128 * Kbytes; lda2 = (unsigned)lda_bytes; hstepA = 128u * lda2; G = G_; c = c_; }
    __device__ __forceinline__ void init_plain(int K, int lda_elems, int G_, int c_) {
        nt = K / 64; kstepA = 128u; kstepB = 128u; ldb2 = (unsigned)K * 2u; hstepB = (size_t)128 * K * 2; lda2 = (unsigned)lda_elems * 2u; hstepA = 128u * lda2; G = G_; c = c_; }
};

struct GemmG1 : GemmBase {
    static constexpr bool FP8 = true; static constexpr int PERMK = 2;
    const unsigned char* A; const unsigned char* Bt; unsigned char* O; const float* bias;
    __device__ __forceinline__ bool next(int i, pg8::Unit& u) const { int pm, pn; if (!pg8::static_unit((long)i * G + c, NTOK / 256, 16, pm, pn)) return false;
        u.a = (const char*)A + (size_t)pm * 256 * D; u.b = (const char*)Bt + (size_t)pn * 256 * D; u.x = pm; u.y = pn; return true; }
    __device__ __forceinline__ void epi(const pg8::Acc& acc, const pg8::Unit& u, int wr, int wc, int fr, int fq) const {
        const int row0 = u.x * 256 + wr * 64 + fr, col0 = u.y * 256 + wc * 64 + 16 * fq;
        constexpr float SA = 1.0f / SC_AWI;
        f32x4 bv[2][2];
#pragma unroll
        for (int bj = 0; bj < 2; ++bj)
#pragma unroll
            for (int n = 0; n < 2; ++n) bv[bj][n] = *(const f32x4*)(bias + col0 + 8 * bj + 4 * n);
#pragma unroll
        for (int ai = 0; ai < 2; ++ai)
#pragma unroll
            for (int m = 0; m < 4; ++m) { u32x4 w;
#pragma unroll
                for (int bj = 0; bj < 2; ++bj) { const f32x4 v0 = acc[ai][bj][m][0] * SA + bv[bj][0], v1 = acc[ai][bj][m][1] * SA + bv[bj][1];
                    static_assert(SC_UV == 8.0f, "gelu2x8"); const f32x2 r0 = gelu2x8(LO2(v0)), r1 = gelu2x8(HI2(v0)), r2 = gelu2x8(LO2(v1)), r3 = gelu2x8(HI2(v1));
                    w[2 * bj] = pk4_fp8_nc(r0.x, r0.y, r1.x, r1.y); w[2 * bj + 1] = pk4_fp8_nc(r2.x, r2.y, r3.x, r3.y); }
                *(u32x4*)(O + (size_t)(row0 + ai * 128 + m * 16) * 4096 + col0) = w; }
    }
};

struct GemmG3 : GemmBase {
    static constexpr bool FP8 = true; static constexpr int PERMK = 2;
    const unsigned char* A; const unsigned char* Bt; bf16_t* Z; const bf16_t* R;
    __device__ __forceinline__ bool next(int i, pg8::Unit& u) const { int pm, pn; if (!pg8::static_unit((long)i * G + c, NTOK / 256, 8, pm, pn)) return false;
        u.a = (const char*)A + (size_t)pm * 256 * D; u.b = (const char*)Bt + (size_t)pn * 256 * D; u.x = pm; u.y = pn; return true; }
    __device__ __forceinline__ void epi(const pg8::Acc& acc, const pg8::Unit& u, int wr, int wc, int fr, int fq) const {
        const int row0 = u.x * 256 + wr * 64 + fr, col0 = u.y * 256 + wc * 64 + 16 * fq;
        constexpr float SM = SC_Z / (SC_P * SC_AWO);
        unsigned char* Z8 = (unsigned char*)Z;
#pragma unroll
        for (int ai = 0; ai < 2; ++ai)
#pragma unroll
            for (int m = 0; m < 4; ++m) { u32x4 w;
#pragma unroll
                for (int bj = 0; bj < 2; ++bj) { const f32x4 v0 = acc[ai][bj][m][0] * SM, v1 = acc[ai][bj][m][1] * SM; w[2 * bj] = pk4_fp8_nc(v0[0], v0[1], v0[2], v0[3]); w[2 * bj + 1] = pk4_fp8_nc(v1[0], v1[1], v1[2], v1[3]); }
                *(u32x4*)(Z8 + (size_t)(row0 + ai * 128 + m * 16) * D + col0) = w; }
    }
};

struct GemmS1 : GemmBase {
    static constexpr bool FP8 = true; static constexpr int PERMK = 2;
    const unsigned char* A; const unsigned char* Bt; bf16_t* A2;
    __device__ __forceinline__ bool next(int i, pg8::Unit& u) const { int pm, pn; if (!pg8::static_unit((long)i * G + c, NTOK / 256, 4, pm, pn)) return false;
        u.a = (const char*)A + (size_t)pm * 256 * D; u.b = (const char*)Bt + (size_t)pn * 256 * D; u.x = pm; u.y = pn; return true; }
    __device__ __forceinline__ void epi(const pg8::Acc& acc, const pg8::Unit& u, int wr, int wc, int fr, int fq) const {
        const int row0 = u.x * 256 + wr * 64 + fr, col0 = u.y * 256 + wc * 64 + 16 * fq;
        constexpr float SU = 1.0f / SC_BW;
        const int gg = col0 >> 4;
#pragma unroll
        for (int ai = 0; ai < 2; ++ai)
#pragma unroll
            for (int m = 0; m < 4; ++m) { const int tok = row0 + ai * 128 + m * 16; const int rr = tok >> 4, ii = tok & 15; bf16_t* dst = A2 + ((size_t)gg * 2048 + rr) * 384 + ii * 16;
#pragma unroll
                for (int bj = 0; bj < 2; ++bj) { const f32x4 v0 = acc[ai][bj][m][0] * SU, v1 = acc[ai][bj][m][1] * SU;
                    u32x4 w; w.x = cvt_pk_bf16(v0[0], v0[1]); w.y = cvt_pk_bf16(v0[2], v0[3]); w.z = cvt_pk_bf16(v1[0], v1[1]); w.w = cvt_pk_bf16(v1[2], v1[3]);
                    *(u32x4*)(dst + bj * 8) = w; } }
    }
};

struct GemmS2 : GemmBase {
    static constexpr int PERMK = 0;
    const bf16_t* A2; const bf16_t* Et; float* Xend;
    __device__ __forceinline__ bool next(int i, pg8::Unit& u) const { const long v = (long)i * G + c; if (v >= 512) return false; const int gg = (int)(v >> 3), pm = (int)(v & 7);
        u.a = (const char*)A2 + ((size_t)gg * 2048 + pm * 256) * 384 * 2; u.b = (const char*)Et + (size_t)gg * 256 * 256 * 2; u.x = gg; u.y = pm; return true; }
    __device__ __forceinline__ void epi(const pg8::Acc& acc, const pg8::Unit& u, int wr, int wc, int fr, int fq) const {
        const int row0 = u.y * 256 + wr * 64 + fr, col0 = wc * 32 + 4 * fq;
#pragma unroll
        for (int ai = 0; ai < 2; ++ai)
#pragma unroll
            for (int m = 0; m < 4; ++m) { float* rowp = Xend + ((size_t)u.x * 2048 + row0 + ai * 128 + m * 16) * 128 + col0;
#pragma unroll
                for (int n = 0; n < 2; ++n) *(f32x4*)(rowp + n * 16) = acc[ai][0][m][n]; }
    }
};

struct GemmS4 : GemmBase {
    static constexpr int PERMK = 2;
    const bf16_t* A2; const bf16_t* Bs; unsigned char* Y;
    __device__ __forceinline__ bool next(int i, pg8::Unit& u) const { const long v = (long)i * G + c; if (v >= 512) return false; const int gg = (int)(v >> 3), pm = (int)(v & 7);
        u.a = (const char*)A2 + ((size_t)gg * 2048 + pm * 256) * 384 * 2; u.b = (const char*)Bs + (size_t)gg * 256 * 384 * 2; u.x = gg; u.y = pm; return true; }
    __device__ __forceinline__ void epi(const pg8::Acc& acc, const pg8::Unit& u, int wr, int wc, int fr, int fq) const {
        const int row0 = u.y * 256 + wr * 64 + fr, col0 = wc * 64 + 16 * fq;
#pragma unroll
        for (int ai = 0; ai < 2; ++ai)
#pragma unroll
            for (int m = 0; m < 4; ++m) { u32x4 w;
#pragma unroll
                for (int bj = 0; bj < 2; ++bj) { const f32x4 v0 = acc[ai][bj][m][0], v1 = acc[ai][bj][m][1];
                    static_assert(SC_YS == 8.0f, "gelu2x8"); const f32x2 r0 = gelu2x8(LO2(v0)), r1 = gelu2x8(HI2(v0)), r2 = gelu2x8(LO2(v1)), r3 = gelu2x8(HI2(v1));
                    w[2 * bj] = pk4_fp8_nc(r0.x, r0.y, r1.x, r1.y); w[2 * bj + 1] = pk4_fp8_nc(r2.x, r2.y, r3.x, r3.y); }
                *(u32x4*)(Y + ((size_t)u.x * 2048 + row0 + ai * 128 + m * 16) * 256 + col0) = w; }
    }
};

struct GemmS5 : GemmBase {
    static constexpr bool FP8 = true;
    const unsigned char* Y; const unsigned char* Bt; bf16_t* Z; const bf16_t* R;
    __device__ __forceinline__ unsigned voffA(int Rr, int C, int h) const { return (unsigned)((C >> 3) * 2048 * 256 + (Rr >> 4) * 256 + (Rr & 15) * 16 + h * 2048); }
    __device__ __forceinline__ bool next(int i, pg8::Unit& u) const { int pm, pn; if (!pg8::static_unit((long)i * G + c, NTOK / 256, 16, pm, pn)) return false;
        u.a = (const char*)Y + (size_t)pm * 16 * 256; u.b = (const char*)Bt + (size_t)pn * 256 * BW; u.x = pm; u.y = pn; return true; }
    __device__ __forceinline__ void epi(const pg8::Acc& acc, const pg8::Unit& u, int wr, int wc, int fr, int fq) const {
        const int row0 = u.x * 256 + wr * 64 + fr, col0 = u.y * 128 + wc * 32 + 8 * fq;
        constexpr float SV = 1.0f / (SC_YS * SC_BW);
#pragma unroll
        for (int ai = 0; ai < 2; ++ai)
#pragma unroll
            for (int m = 0; m < 4; ++m) { const size_t off = (size_t)(row0 + ai * 128 + m * 16) * D + col0;
                const f32x4 a0 = acc[ai][0][m][0] * SV, a1 = acc[ai][0][m][1] * SV, g0 = acc[ai][1][m][0] * SV, g1 = acc[ai][1][m][1] * SV;
                const f32x2 r0 = LO2(a0) * sig2(LO2(g0)) * SC_Z, r1 = HI2(a0) * sig2(HI2(g0)) * SC_Z, r2 = LO2(a1) * sig2(LO2(g1)) * SC_Z, r3 = HI2(a1) * sig2(HI2(g1)) * SC_Z;
                u32x2 w; w.x = pk4_fp8_nc(r0.x, r0.y, r1.x, r1.y); w.y = pk4_fp8_nc(r2.x, r2.y, r3.x, r3.y);
                *(u32x2*)((unsigned char*)Z + off) = w; }
    }
};

struct MoeTab { const LAS int* tp; const LAS int* sb; const LAS int* cnt; int nU; };
__device__ __forceinline__ bool moe_unit(const MoeTab& T, long L, int& e, int& mt, int& pn) {
    const int nU = T.nU; if (L >= nU) return false;
    int v; { const int q = nU / 8, r = nU % 8, xcd = (int)(L % 8), off = (int)(L / 8); v = (xcd < r ? xcd * (q + 1) : r * (q + 1) + (xcd - r) * q) + off; }
    const int tile = v >> 3;
    int ee = 0;
#pragma unroll
    for (int j = 1; j < 16; ++j) ee += (tile >= __builtin_amdgcn_readfirstlane(T.tp[j])) ? 1 : 0;
    const int tp0 = __builtin_amdgcn_readfirstlane(T.tp[ee]), tp1 = __builtin_amdgcn_readfirstlane(T.tp[ee + 1]);
    const int tiles_e = tp1 - tp0, ve = v - 8 * tp0;
    const int gid = ve >> 6, fm = gid * 8, gsz = (tiles_e - fm) < 8 ? (tiles_e - fm) : 8, rem = ve - 64 * gid;
    e = ee; mt = fm + rem % gsz; pn = rem / gsz; return true;
}

struct GemmM1 : GemmBase {
    static constexpr bool GATHER = true, FP8 = true;
    const unsigned char* H8; const unsigned char* Bt; unsigned char* ACT; MoeTab T; const LAS int* rows;
    __device__ __forceinline__ unsigned gatherA(int ui, int Rr, int C, int h) const { return (unsigned)rows[ui * 256 + h * 128 + Rr] * (unsigned)D + (unsigned)C * 2u; }
    __device__ __forceinline__ bool next(int i, pg8::Unit& u) const { int e, mt, pn; if (!moe_unit(T, (long)i * G + c, e, mt, pn)) return false;
        u.a = (const char*)H8; u.b = (const char*)Bt + ((size_t)e * 2048 + pn * 256) * D; u.x = __builtin_amdgcn_readfirstlane(T.sb[e]) + mt * 256; u.y = pn; u.z = e; u.w = mt; return true; }
    __device__ __forceinline__ void epi(const pg8::Acc& acc, const pg8::Unit& u, int wr, int wc, int fr, int fq) const {
        const int row0 = u.x + wr * 64 + fr, col0 = u.y * 128 + wc * 32 + 8 * fq;
        constexpr float SG = 1.0f / SC_WIN, SU = SC_ACT / SC_WIN;
#pragma unroll
        for (int ai = 0; ai < 2; ++ai)
#pragma unroll
            for (int m = 0; m < 4; ++m) { const f32x4 a0 = acc[ai][0][m][0] * SG, a1 = acc[ai][0][m][1] * SG, u0 = acc[ai][1][m][0] * SU, u1 = acc[ai][1][m][1] * SU;
                const f32x2 r0 = LO2(a0) * sig2(LO2(a0)) * LO2(u0), r1 = HI2(a0) * sig2(HI2(a0)) * HI2(u0), r2 = LO2(a1) * sig2(LO2(a1)) * LO2(u1), r3 = HI2(a1) * sig2(HI2(a1)) * HI2(u1);
                u32x2 w; w.x = pk4_fp8(r0.x, r0.y, r1.x, r1.y); w.y = pk4_fp8(r2.x, r2.y, r3.x, r3.y);
                *(u32x2*)(ACT + (size_t)(row0 + ai * 128 + m * 16) * DFF + col0) = w; }
    }
};
struct GemmM2 : GemmBase {
    static constexpr bool FP8 = true; static constexpr int PERMK = 2;
    const unsigned char* ACT; const unsigned char* Bt; unsigned char* YB; MoeTab T;
    __device__ __forceinline__ bool next(int i, pg8::Unit& u) const { int e, mt, pn; if (!moe_unit(T, (long)i * G + c, e, mt, pn)) return false;
        const int r0 = __builtin_amdgcn_readfirstlane(T.sb[e]) + mt * 256; u.a = (const char*)ACT + (size_t)r0 * DFF; u.b = (const char*)Bt + ((size_t)e * 2048 + pn * 256) * DFF; u.x = r0; u.y = pn; return true; }
    __device__ __forceinline__ void epi(const pg8::Acc& acc, const pg8::Unit& u, int wr, int wc, int fr, int fq) const {
        const int row0 = u.x + wr * 64 + fr, col0 = u.y * 256 + wc * 64 + 16 * fq;
        constexpr float SY = SC_Y / (SC_ACT * SC_WOUT);
#pragma unroll
        for (int ai = 0; ai < 2; ++ai)
#pragma unroll
            for (int m = 0; m < 4; ++m) { u32x4 w;
#pragma unroll
                for (int bj = 0; bj < 2; ++bj) { const f32x4 v0 = acc[ai][bj][m][0] * SY, v1 = acc[ai][bj][m][1] * SY;
                    w[2 * bj] = pk4_fp8_nc(v0[0], v0[1], v0[2], v0[3]); w[2 * bj + 1] = pk4_fp8_nc(v1[0], v1[1], v1[2], v1[3]); }
                *(u32x4*)(YB + (size_t)(row0 + ai * 128 + m * 16) * D + col0) = w; }
    }
};

struct Args { const float* in[26]; float* out; unsigned char* ws; int ph_lo, ph_hi, flags, pad; };
struct Frame {
    LAS unsigned char* lds; unsigned char* ws; unsigned* ctl;
    int tid, lane, wave, G, bx;
};

__device__ __forceinline__ void transpose_item(const float* __restrict__ src, int ldsrc, int k0, int srccol0, bf16_t* __restrict__ dst, int ldt, int dstrow0, LAS unsigned char* scr, int tid) {
    const int a = tid >> 5, nq = tid & 31;
    f32x4 v[8];
#pragma unroll
    for (int r = 0; r < 8; ++r) v[r] = *(const f32x4*)(src + (size_t)(k0 + 8 * a + r) * ldsrc + srccol0 + 4 * nq);
#pragma unroll
    for (int j = 0; j < 4; ++j) { u32x4 w; w.x = cvt_pk_bf16(v[0][j], v[1][j]); w.y = cvt_pk_bf16(v[2][j], v[3][j]); w.z = cvt_pk_bf16(v[4][j], v[5][j]); w.w = cvt_pk_bf16(v[6][j], v[7][j]);
        const int n = 4 * nq + j; *(LAS u32x4*)(scr + n * 256 + ((a ^ ((n >> 2) & 15)) << 4)) = w; }
    __syncthreads();
#pragma unroll
    for (int q = 0; q < 4; ++q) { const int idx = tid + 512 * q, n = idx >> 4, ch = idx & 15;
        const u32x4 w = *(const LAS u32x4*)(scr + n * 256 + ((ch ^ ((n >> 2) & 15)) << 4));
        *(u32x4*)(dst + (size_t)(dstrow0 + n) * ldt + k0 + 8 * ch) = w; }
    __syncthreads();
}
__device__ __forceinline__ void transpose_item_f8(const float* __restrict__ src, int ldsrc, int k0, int srccol0, unsigned char* __restrict__ dst, int ldt, int dstrow0, float sc, LAS unsigned char* scr, int tid) {
    const int a = tid >> 5, nq = tid & 31;
#pragma unroll
    for (int h = 0; h < 2; ++h) {
        f32x4 v[8];
#pragma unroll
        for (int r = 0; r < 8; ++r) v[r] = *(const f32x4*)(src + (size_t)(k0 + 128 * h + 8 * a + r) * ldsrc + srccol0 + 4 * nq) * sc;
#pragma unroll
        for (int j = 0; j < 4; ++j) { u32x2 w; w.x = pk4_fp8(v[0][j], v[1][j], v[2][j], v[3][j]); w.y = pk4_fp8(v[4][j], v[5][j], v[6][j], v[7][j]);
            const int n = 4 * nq + j, c16 = 8 * h + (a >> 1); *(LAS u32x2*)(scr + n * 256 + ((c16 ^ ((n >> 2) & 15)) << 4) + (a & 1) * 8) = w; }
    }
    __syncthreads();
#pragma unroll
    for (int q = 0; q < 4; ++q) { const int idx = tid + 512 * q, n = idx >> 4, ch = idx & 15;
        const u32x4 w = *(const LAS u32x4*)(scr + n * 256 + ((ch ^ ((n >> 2) & 15)) << 4));
        *(u32x4*)(dst + (size_t)(dstrow0 + n) * ldt + k0 + 16 * ch) = w; }
    __syncthreads();
}
__device__ __forceinline__ void transpose_job_f8(Frame& F, const float* src, unsigned char* dst, int nmat, int K, int N, bool glu, float sc, int& itbase) {
    const int kb = K / 256, nb = N / 128, per = kb * nb, total = nmat * per;
    int first = (F.bx - itbase % F.G + F.G) % F.G;
    for (int it = first; it < total; it += F.G) {
        const int m = it / per, r = it % per, kk = r / nb, nn = r % nb;
        const int srccol0 = glu ? ((nn & 1) * (N / 2) + (nn >> 1) * 128) : nn * 128;
        transpose_item_f8(src + (size_t)m * K * N, N, kk * 256, srccol0, dst + (size_t)m * K * N, K, nn * 128, sc, F.lds, F.tid);
    }
    itbase += total;
}
__device__ __forceinline__ void transpose_job(Frame& F, const float* src, bf16_t* dst, int nmat, int K, int N, bool glu, int& itbase) {
    const int kb = K / 128, nb = N / 128, per = kb * nb, total = nmat * per;
    int first = (F.bx - itbase % F.G + F.G) % F.G;
    for (int it = first; it < total; it += F.G) {
        const int m = it / per, r = it % per, kk = r / nb, nn = r % nb;
        const int srccol0 = glu ? ((nn & 1) * (N / 2) + (nn >> 1) * 128) : nn * 128;
        transpose_item(src + (size_t)m * K * N, N, kk * 128, srccol0, dst + (size_t)m * K * N, K, nn * 128, F.lds, F.tid);
    }
    itbase += total;
}

__device__ __forceinline__ void ssm_precompute(Frame& F, const float* const* in, int g) {
    const float* a_re = in[9]; const float* a_im = in[10]; const float* log_dt = in[11]; const float* b_re = in[12]; const float* b_im = in[13];
    const float* c_re = in[14]; const float* c_im = in[15]; const float* dsk = in[16];
    LAS float* PW = (LAS float*)F.lds;
    LAS float* BB = PW + 64 * 17 * 2;
    LAS float* CC = BB + 64 * 16 * 2;
    LAS float* KM = CC + 16 * 64 * 2;
    bf16_t* Bs = (bf16_t*)(F.ws + WS_SSMB) + (size_t)g * 256 * 384;
    bf16_t* Et = (bf16_t*)(F.ws + WS_SSME) + (size_t)g * 256 * 256;
    const float dt = expf(log_dt[g]);
    __syncthreads();
    for (int idx = F.tid; idx < 64 * 17; idx += NTHR) { const int p = idx / 17, k = idx % 17; const float zr = a_re[g * 64 + p] * dt * (float)k, zi = a_im[g * 64 + p] * dt * (float)k;
        const float mag = expf(zr); float sn, cs; sincosf(zi, &sn, &cs); PW[idx * 2] = mag * cs; PW[idx * 2 + 1] = mag * sn; }
    for (int idx = F.tid; idx < 64 * 16; idx += NTHR) { const int p = idx >> 4, c = idx & 15; const float ar = a_re[g * 64 + p], ai = a_im[g * 64 + p];
        const float zr = ar * dt, zi = ai * dt; const float mag = expf(zr); float sn, cs; sincosf(zi, &sn, &cs);
        const float nr = mag * cs - 1.0f, ni = mag * sn;
        const float den = 1.0f / (ar * ar + ai * ai); const float qr = (nr * ar + ni * ai) * den, qi = (ni * ar - nr * ai) * den;
        const float br = b_re[(g * 64 + p) * 16 + c], bi = b_im[(g * 64 + p) * 16 + c];
        BB[idx * 2] = qr * br - qi * bi; BB[idx * 2 + 1] = qr * bi + qi * br; }
    for (int idx = F.tid; idx < 16 * 64; idx += NTHR) { const int c = idx >> 6, p = idx & 63; CC[idx * 2] = c_re[(g * 16 + c) * 64 + p]; CC[idx * 2 + 1] = c_im[(g * 16 + c) * 64 + p]; }
    __syncthreads();
    for (int idx = F.tid; idx < 4096; idx += NTHR) { const int k = idx >> 8, c = (idx >> 4) & 15, cp = idx & 15; float s = 0.f;
        for (int p = 0; p < 64; ++p) { const float cr = CC[(c * 64 + p) * 2], ci = CC[(c * 64 + p) * 2 + 1], pr = PW[(p * 17 + k) * 2], pi = PW[(p * 17 + k) * 2 + 1], br = BB[(p * 16 + cp) * 2], bi = BB[(p * 16 + cp) * 2 + 1];
            const float tr = cr * pr - ci * pi, ti = cr * pi + ci * pr; s += tr * br - ti * bi; }
        KM[idx] = s; }
    __syncthreads();
    for (int idx = F.tid; idx < 256 * 256; idx += NTHR) { const int n = idx >> 8, kq = idx & 255, i = n >> 4, c = n & 15, ip = kq >> 4, cp = kq & 15;
        float v = 0.f; if (ip <= i) v = KM[((i - ip) * 16 + c) * 16 + cp]; if (ip == i && c == cp) v += dsk[g * 16 + c];
        Bs[(size_t)n * 384 + kq] = (bf16_t)f2bf(v); }
    for (int idx = F.tid; idx < 256 * 64; idx += NTHR) { const int n = idx >> 6, p = idx & 63, i = n >> 4, c = n & 15;
        const float cr = CC[(c * 64 + p) * 2], ci = CC[(c * 64 + p) * 2 + 1], pr = PW[(p * 17 + i + 1) * 2], pi = PW[(p * 17 + i + 1) * 2 + 1];
        Bs[(size_t)n * 384 + 256 + p] = (bf16_t)f2bf(cr * pr - ci * pi); Bs[(size_t)n * 384 + 320 + p] = (bf16_t)f2bf(-(cr * pi + ci * pr)); }
    for (int idx = F.tid; idx < 256 * 256; idx += NTHR) { const int n = idx >> 8, kq = idx & 255, ip = kq >> 4, cp = kq & 15; float v = 0.f;
        if (n < 128) { const int p = n & 63; const float pr = PW[(p * 17 + 15 - ip) * 2], pi = PW[(p * 17 + 15 - ip) * 2 + 1], br = BB[(p * 16 + cp) * 2], bi = BB[(p * 16 + cp) * 2 + 1];
            v = (n < 64) ? (pr * br - pi * bi) : (pr * bi + pi * br); }
        Et[(size_t)n * 256 + kq] = (bf16_t)f2bf(v); }
    __syncthreads();
}

__device__ __forceinline__ void p0_prologue(Frame& F, const float* const* in) {
    unsigned char* ws = F.ws;
    if (F.bx < 64) ssm_precompute(F, in, F.bx);
    { const float* w_s = in[5]; bf16_t* wt = (bf16_t*)(ws + WS_WTRIL);
      for (int idx = F.bx * NTHR + F.tid; idx < 8 * 128 * 128; idx += F.G * NTHR) { const int t = (idx >> 7) & 127, s = idx & 127; wt[idx] = (s <= t) ? (bf16_t)f2bf(w_s[idx]) : (bf16_t)0; } }
    { const float* rw = in[20]; u32x4* rwf = (u32x4*)(ws + WS_RWF);
      for (int idx = F.bx * NTHR + F.tid; idx < 8 * 8 * 64; idx += F.G * NTHR) { const int ln = idx & 63, kk = (idx >> 6) & 7, wv = idx >> 9, e = ln & 15, q = ln >> 4;
          unsigned hi[8], lo[8];
#pragma unroll
          for (int j = 0; j < 8; ++j) { const float w = rw[(size_t)(256 * wv + 32 * kk + 8 * q + j) * 16 + e]; hi[j] = f2bf(w); lo[j] = f2bf(w - __uint_as_float(hi[j] << 16)); }
          rwf[((wv * 8 + kk) * 2) * 64 + ln] = (u32x4){hi[0] | (hi[1] << 16), hi[2] | (hi[3] << 16), hi[4] | (hi[5] << 16), hi[6] | (hi[7] << 16)};
          rwf[((wv * 8 + kk) * 2 + 1) * 64 + ln] = (u32x4){lo[0] | (lo[1] << 16), lo[2] | (lo[3] << 16), lo[4] | (lo[5] << 16), lo[6] | (lo[7] << 16)}; } }
    int itbase = 0;
    transpose_job_f8(F, in[1], ws + WS_WIN, 1, 2048, 4096, false, SC_AWI, itbase);
    transpose_job_f8(F, in[7], ws + WS_WOUT, 1, 2048, 2048, false, SC_AWO, itbase);
    transpose_job_f8(F, in[8], ws + WS_BWIN, 1, 2048, 1024, false, SC_BW, itbase);
    transpose_job_f8(F, in[17], ws + WS_BWOUT, 1, 1024, 4096, true, SC_BW, itbase);
    { const float* x = in[0]; bf16_t* xb = (bf16_t*)(ws + WS_A); unsigned char* x8 = ws + WS_X8;
      constexpr int NBLK = (int)((size_t)NTOK * D / 8 / 2048);
      LAS int* qv = (LAS int*)(F.lds + LDS_MOE + 448);
      for (;;) { __syncthreads(); if (F.tid == 0) *qv = (int)__hip_atomic_fetch_add(F.ctl + CW_XQ, 1u, __ATOMIC_RELAXED, __HIP_MEMORY_SCOPE_AGENT);
          __syncthreads(); const int blk = __builtin_amdgcn_readfirstlane(*qv); if (blk >= NBLK) break;
          f32x4 a[4], b[4];
#pragma unroll
          for (int q = 0; q < 4; ++q) { const size_t i = (size_t)blk * 2048 + q * 512 + F.tid; a[q] = *(const f32x4*)(x + i * 8); b[q] = *(const f32x4*)(x + i * 8 + 4); }
#pragma unroll
          for (int q = 0; q < 4; ++q) { const size_t i = (size_t)blk * 2048 + q * 512 + F.tid;
              u32x4 w; w.x = cvt_pk_bf16(a[q][0], a[q][1]); w.y = cvt_pk_bf16(a[q][2], a[q][3]); w.z = cvt_pk_bf16(b[q][0], b[q][1]); w.w = cvt_pk_bf16(b[q][2], b[q][3]); *(u32x4*)(xb + i * 8) = w;
              u32x2 w8; w8.x = pk4_fp8(a[q][0], a[q][1], a[q][2], a[q][3]); w8.y = pk4_fp8(b[q][0], b[q][1], b[q][2], b[q][3]); *(u32x2*)(x8 + i * 8) = w8; } } }
}

__device__ __forceinline__ int fV(int d) { return (d & 3) | (((d >> 4) & 3) << 2); }
__device__ __forceinline__ void g2_phase(Frame& F, const float* const* in) {
    const unsigned char* UV = F.ws + WS_B; const bf16_t* WT = (const bf16_t*)(F.ws + WS_WTRIL); unsigned char* P8 = F.ws + WS_H8;
    const float* lng = in[3]; const float* lnb = in[4]; const float* b_s = in[6];
    LAS unsigned char* VT = F.lds;
    LAS unsigned char* WSM = F.lds + 65536;
    LAS float* ST = (LAS float*)(F.lds + 98304);
    const int tid = F.tid, lane = F.lane, wave = F.wave, fr = lane & 15, fq = lane >> 4;
    const int sblk = tid >> 5, dblk = tid & 31;
    for (int ch = F.bx; ch < NTOK / CHUNK; ch += F.G) {
        const int tok0 = ch * CHUNK;
        const unsigned char* cUV = UV + (size_t)tok0 * 4096; unsigned char* cP8 = P8 + (size_t)tok0 * D;
        __syncthreads();
#pragma unroll 1
        for (int hb = 0; hb < 2; ++hb) {
            u32x4 w[8][2];
            unsigned so = (unsigned)((wave * 16 + hb * 8) * 4096 + 2048 + lane * 16); asm volatile("" : "+v"(so));
#pragma unroll
            for (int rr = 0; rr < 8; ++rr) { w[rr][0] = *(const u32x4*)(cUV + (so + rr * 4096u)); w[rr][1] = *(const u32x4*)(cUV + (so + rr * 4096u + 1024u)); }
#pragma unroll
            for (int rr = 0; rr < 8; ++rr) { float s = 0.f, s2 = 0.f;
#pragma unroll
                for (int j = 0; j < 2; ++j)
#pragma unroll
                    for (int q = 0; q < 4; ++q) { float f[4]; unpk4_fp8(w[rr][j][q], f);
#pragma unroll
                        for (int e = 0; e < 4; ++e) { s += f[e]; s2 += f[e] * f[e]; } }
                s = wave_sum(s) * (1.0f / SC_UV); s2 = wave_sum(s2) * (1.0f / (SC_UV * SC_UV));
                const float mu = s * (1.0f / 2048.0f), var = s2 * (1.0f / 2048.0f) - mu * mu; const int r = wave * 16 + hb * 8 + rr;
                if (lane == 0) { ST[r * 2] = mu; ST[r * 2 + 1] = 1.0f / sqrtf(fmaxf(var, 0.f) + LN_EPS); } }
        }
        u32x4 wreg[4]; u32x2 vreg[8]; f32x4 gbr[4];
#define G2_LOAD(gg) do { _Pragma("unroll") for (int q = 0; q < 4; ++q) { const int idx = tid + 512 * q; wreg[q] = *(const u32x4*)(WT + ((size_t)(gg) * 128 + (idx >> 4)) * 128 + (idx & 15) * 8); } \
            const int dc_ = (gg) * 256 + dblk * 8; unsigned vo_ = (unsigned)(sblk * 8 * 4096 + 2048 + dc_); asm volatile("" : "+v"(vo_)); \
            _Pragma("unroll") for (int r = 0; r < 8; ++r) vreg[r] = *(const u32x2*)(cUV + (vo_ + r * 4096u)); \
            gbr[0] = *(const f32x4*)(lng + dc_); gbr[1] = *(const f32x4*)(lng + dc_ + 4); gbr[2] = *(const f32x4*)(lnb + dc_); gbr[3] = *(const f32x4*)(lnb + dc_ + 4); } while (0)
        G2_LOAD(0);
        __syncthreads();
#pragma unroll 1
        for (int g = 0; g < AG; ++g) {
#pragma unroll
            for (int q = 0; q < 4; ++q) { const int idx = tid + 512 * q, t = idx >> 4, c16 = idx & 15; *(LAS u32x4*)(WSM + t * 256 + ((c16 ^ (t & 15)) << 4)) = wreg[q]; }
            { unsigned pk[4][8];
#pragma unroll
              for (int rp = 0; rp < 4; ++rp) { const int s0 = sblk * 8 + 2 * rp; const f32x4 st = *(const LAS f32x4*)(ST + s0 * 2);
                  float f0[8], f1[8]; unpk4_fp8(vreg[2 * rp].x, f0); unpk4_fp8(vreg[2 * rp].y, f0 + 4); unpk4_fp8(vreg[2 * rp + 1].x, f1); unpk4_fp8(vreg[2 * rp + 1].y, f1 + 4);
#pragma unroll
                  for (int q = 0; q < 8; ++q) { const float gq = gbr[q >> 2][q & 3], bq = gbr[2 + (q >> 2)][q & 3];
                      pk[rp][q] = cvt_pk_bf16((f0[q] * (1.0f / SC_UV) - st[0]) * st[1] * gq + bq, (f1[q] * (1.0f / SC_UV) - st[2]) * st[3] * gq + bq); } }
#pragma unroll
              for (int j = 0; j < 8; ++j) { const int d = dblk * 8 + j; u32x4 w; w.x = pk[0][j]; w.y = pk[1][j]; w.z = pk[2][j]; w.w = pk[3][j];
                  *(LAS u32x4*)(VT + d * 256 + ((sblk ^ fV(d)) << 4)) = w; } }
            __syncthreads();
            if (g + 1 < AG) G2_LOAD(g + 1);
            const int wd = wave & 3, wt = wave >> 2;
            u32x4 ureg[4]; float bsr[4];
            unsigned uo = (unsigned)(fr * 4096 + g * 256 + wd * 64 + 16 * fq); asm volatile("" : "+v"(uo));
#pragma unroll
            for (int mi = 0; mi < 4; ++mi) { const int m = 2 * mi + (((mi & 1) ^ wt) ? 1 : 0); ureg[mi] = *(const u32x4*)(cUV + (uo + (unsigned)m * 65536u)); bsr[mi] = b_s[g * 128 + 16 * m + fr]; }
            f32x4 acc[4][4];
#pragma unroll
            for (int mi = 0; mi < 4; ++mi)
#pragma unroll
                for (int n = 0; n < 4; ++n) acc[mi][n] = (f32x4){0.f, 0.f, 0.f, 0.f};
#pragma unroll
            for (int ks = 0; ks < 4; ++ks) {
                bf16x8 bfr[4];
#pragma unroll
                for (int n = 0; n < 4; ++n) { const int d = wd * 64 + 16 * (fr >> 2) + 4 * n + (fr & 3); bfr[n] = *(const LAS bf16x8*)(VT + d * 256 + (((4 * ks + fq) ^ fV(d)) << 4)); }
#pragma unroll
                for (int mi = 0; mi < 4; ++mi) { const int m = 2 * mi + (((mi & 1) ^ wt) ? 1 : 0);
                    if (m >= 2 * ks) { const int t = 16 * m + fr; const bf16x8 afr = *(const LAS bf16x8*)(WSM + t * 256 + (((4 * ks + fq) ^ (t & 15)) << 4));
#pragma unroll
                        for (int n = 0; n < 4; ++n) acc[mi][n] = __builtin_amdgcn_mfma_f32_16x16x32_bf16(bfr[n], afr, acc[mi][n], 0, 0, 0); } }
            }
            unsigned po = (unsigned)(fr * D + g * 256 + wd * 64 + 16 * fq); asm volatile("" : "+v"(po));
#pragma unroll
            for (int mi = 0; mi < 4; ++mi) { const int m = 2 * mi + (((mi & 1) ^ wt) ? 1 : 0); const float bs = bsr[mi]; constexpr float SPU = SC_P / SC_UV; u32x4 w;
#pragma unroll
                for (int n = 0; n < 4; ++n) { float f[4]; unpk4_fp8(ureg[mi][n], f);
                    w[n] = pk4_fp8(SPU * f[0] * (acc[mi][n][0] + bs), SPU * f[1] * (acc[mi][n][1] + bs), SPU * f[2] * (acc[mi][n][2] + bs), SPU * f[3] * (acc[mi][n][3] + bs)); }
                *(u32x4*)(cP8 + (po + (unsigned)m * 16u * D)) = w; }
            __syncthreads();
        }
#undef G2_LOAD
    }
}

__device__ __forceinline__ void ln_route_phase(Frame& F, const float* const* in, int layer) {
    const bf16_t* Z = (const bf16_t*)(F.ws + WS_C); const bf16_t* RES = (const bf16_t*)(F.ws + WS_A); bf16_t* H = (bf16_t*)(F.ws + WS_D); unsigned char* H8 = F.ws + WS_H8;
    const float* lng = in[18] + layer * D; const float* lnb = in[19] + layer * D; const float* rw = in[20]; const float* rb = in[21];
    int* rowlist = (int*)(F.ws + WS_ROWLIST); i32x4* toki = (i32x4*)(F.ws + WS_TOKI); f32x2* tokg = (f32x2*)(F.ws + WS_TOKG);
    unsigned* gcnt = F.ctl + CW_CNT + 64 * layer;
    LAS unsigned char* T = F.lds;
    LAS float* PART = (LAS float*)(F.lds + 65792);
    LAS int* LCNT = (LAS int*)(F.lds + 65792 + 8192);
    LAS int* LBASE = LCNT + 16;
    LAS int* TE = LBASE + 16;
    LAS int* TR = TE + 512;
    const int tid = F.tid, lane = F.lane, wave = F.wave, fr = lane & 15, fq = lane >> 4;
    bf16x8 rwh[8], rwl[8];
    { const bf16x8* rwf = (const bf16x8*)(F.ws + WS_RWF) + (size_t)wave * 8 * 2 * 64 + lane;
#pragma unroll
      for (int kk = 0; kk < 8; ++kk) { rwh[kk] = rwf[(kk * 2) * 64]; rwl[kk] = rwf[(kk * 2 + 1) * 64]; } }
    LAS float* GB = (LAS float*)(F.lds + 81920);
    __syncthreads();
    for (int i = tid; i < D / 4; i += NTHR) { *(LAS f32x4*)(GB + 4 * i) = *(const f32x4*)(lng + 4 * i); *(LAS f32x4*)(GB + D + 4 * i) = *(const f32x4*)(lnb + 4 * i); }
    if (tid < 16) LCNT[tid] = 0;
    __syncthreads();
    int nloc = 0;
    for (int it = 0, grp = F.bx; grp < NTOK / 16; ++it, grp += F.G) {
#pragma unroll 1
        for (int rr = 0; rr < 2; ++rr) { const int r = 2 * wave + rr; const size_t tok = (size_t)grp * 16 + r; const bf16_t* zp = Z + tok * D; const bf16_t* rp = RES + tok * D;
            float x[4][8]; float s = 0.f;
#pragma unroll
            for (int j = 0; j < 4; ++j) { const u32x2 w = *(const u32x2*)((const unsigned char*)Z + tok * D + (j * 64 + lane) * 8); const u32x4 rv = *(const u32x4*)(rp + (j * 64 + lane) * 8);
                float f[8]; unpk4_fp8(w.x, f); unpk4_fp8(w.y, f + 4);
#pragma unroll
                for (int q = 0; q < 4; ++q) { x[j][2 * q] = ALPHA * bf_lo(rv[q]) + f[2 * q] * (1.0f / SC_Z); x[j][2 * q + 1] = ALPHA * bf_hi(rv[q]) + f[2 * q + 1] * (1.0f / SC_Z); s += x[j][2 * q] + x[j][2 * q + 1]; } }
            const float mu = wave_sum(s) * (1.0f / D); float s2 = 0.f;
#pragma unroll
            for (int j = 0; j < 4; ++j)
#pragma unroll
                for (int q = 0; q < 8; ++q) { x[j][q] -= mu; s2 += x[j][q] * x[j][q]; }
            const float rs = 1.0f / sqrtf(wave_sum(s2) * (1.0f / D) + LN_EPS);
#pragma unroll
            for (int j = 0; j < 4; ++j) { const int c0 = (j * 64 + lane) * 8;
                const f32x4 g0 = *(const LAS f32x4*)(GB + c0), g1 = *(const LAS f32x4*)(GB + c0 + 4), b0 = *(const LAS f32x4*)(GB + D + c0), b1 = *(const LAS f32x4*)(GB + D + c0 + 4);
                float o[8];
#pragma unroll
                for (int q = 0; q < 4; ++q) { o[q] = x[j][q] * rs * g0[q] + b0[q]; o[4 + q] = x[j][4 + q] * rs * g1[q] + b1[q]; }
                u32x4 w; w.x = cvt_pk_bf16(o[0], o[1]); w.y = cvt_pk_bf16(o[2], o[3]); w.z = cvt_pk_bf16(o[4], o[5]); w.w = cvt_pk_bf16(o[6], o[7]);
                *(u32x4*)(H + tok * D + c0) = w; *(LAS u32x4*)(T + r * 4112 + (j * 64 + lane) * 16) = w;
                u32x2 w8; w8.x = pk4_fp8(o[0], o[1], o[2], o[3]); w8.y = pk4_fp8(o[4], o[5], o[6], o[7]); *(u32x2*)(H8 + tok * D + c0) = w8; } }
        __syncthreads();
        { f32x4 acc = (f32x4){0.f, 0.f, 0.f, 0.f};
#pragma unroll
          for (int kk = 0; kk < 8; ++kk) { const bf16x8 a = *(const LAS bf16x8*)(T + fr * 4112 + (256 * wave + 32 * kk + 8 * fq) * 2);
              acc = __builtin_amdgcn_mfma_f32_16x16x32_bf16(a, rwh[kk], acc, 0, 0, 0); acc = __builtin_amdgcn_mfma_f32_16x16x32_bf16(a, rwl[kk], acc, 0, 0, 0); }
#pragma unroll
          for (int j = 0; j < 4; ++j) PART[(wave * 16 + 4 * fq + j) * 16 + fr] = acc[j]; }
        __syncthreads();
        if (tid < 16) {
            const int r = tid; const int tok = grp * 16 + r; float lg[16]; float mx = -3.0e38f;
#pragma unroll
            for (int e4 = 0; e4 < 4; ++e4) { const f32x4 b4 = *(const f32x4*)(rb + 4 * e4); lg[4 * e4] = b4[0]; lg[4 * e4 + 1] = b4[1]; lg[4 * e4 + 2] = b4[2]; lg[4 * e4 + 3] = b4[3]; }
#pragma unroll 1
            for (int w = 0; w < 8; ++w) {
#pragma unroll
                for (int e4 = 0; e4 < 4; ++e4) { const f32x4 p4 = *(const LAS f32x4*)(PART + (w * 16 + r) * 16 + 4 * e4); lg[4 * e4] += p4[0]; lg[4 * e4 + 1] += p4[1]; lg[4 * e4 + 2] += p4[2]; lg[4 * e4 + 3] += p4[3]; } }
#pragma unroll
            for (int e = 0; e < 16; ++e) mx = fmaxf(mx, lg[e]);
#pragma unroll
            for (int e = 0; e < 16; ++e) lg[e] = __expf(lg[e] - mx);
            int bg = 0; float bscore = -1.f;
#pragma unroll
            for (int gq = 0; gq < 4; ++gq) { float a = -1.f, b = -1.f;
#pragma unroll
                for (int q = 0; q < 4; ++q) { const float p = lg[4 * gq + q]; if (p > a) { b = a; a = p; } else if (p > b) b = p; }
                const float sc = a + b; if (sc > bscore) { bscore = sc; bg = gq; } }
            int i0 = 0, i1 = 0; float p0 = -1.f, p1 = -1.f;
#pragma unroll
            for (int gq = 0; gq < 4; ++gq) if (gq == bg) {
#pragma unroll
                for (int q = 0; q < 4; ++q) { const float p = lg[4 * gq + q]; if (p > p0) { p1 = p0; i1 = i0; p0 = p; i0 = 4 * gq + q; } else if (p > p1) { p1 = p; i1 = 4 * gq + q; } } }
            const float inv = 1.0f / (p0 + p1);
            tokg[tok] = (f32x2){p0 * inv, p1 * inv};
            const int lt = it * 16 + r;
            TE[lt * 2] = i0; TE[lt * 2 + 1] = i1;
            TR[lt * 2] = atomicAdd((int*)&LCNT[i0], 1); TR[lt * 2 + 1] = atomicAdd((int*)&LCNT[i1], 1);
        }
        nloc = it * 16 + 16;
    }
    __syncthreads();
    if (tid < 16) LBASE[tid] = (int)__hip_atomic_fetch_add(gcnt + tid, (unsigned)LCNT[tid], __ATOMIC_RELAXED, __HIP_MEMORY_SCOPE_AGENT);
    __syncthreads();
    for (int lt = tid; lt < nloc; lt += NTHR) { const int it = lt >> 4, r = lt & 15; const int tok = (F.bx + it * F.G) * 16 + r;
        const int e0 = TE[lt * 2], e1 = TE[lt * 2 + 1]; const int s0 = LBASE[e0] + TR[lt * 2], s1 = LBASE[e1] + TR[lt * 2 + 1];
        rowlist[e0 * NTOK + s0] = tok; rowlist[e1 * NTOK + s1] = tok;
        toki[tok] = (i32x4){e0 | (e1 << 8), s0, s1, 0}; }
    __syncthreads();
}

__device__ __forceinline__ MoeTab moe_tables(Frame& F, int layer) {
    LAS int* M = (LAS int*)(F.lds + LDS_MOE);
    __syncthreads();
    if (F.tid == 0) { int tp = 0, sb = 0;
        for (int e = 0; e < 16; ++e) { const int c = (int)__hip_atomic_load(F.ctl + CW_CNT + 64 * layer + e, __ATOMIC_RELAXED, __HIP_MEMORY_SCOPE_AGENT); const int tl = (c + 255) >> 8;
            M[e] = tp; M[32 + e] = sb; M[64 + e] = c; tp += tl; sb += tl * 256; }
        M[16] = tp; }
    __syncthreads();
    MoeTab T; T.tp = M; T.sb = M + 32; T.cnt = M + 64; T.nU = __builtin_amdgcn_readfirstlane(M[16]) * 8; return T;
}

template <bool FINAL>
__device__ __forceinline__ void ln2_phase(Frame& F, const float* const* in, int layer, const MoeTab& T, float* out) {
    const bf16_t* H = (const bf16_t*)(F.ws + WS_D); const unsigned char* YB = F.ws + WS_B; bf16_t* H2 = (bf16_t*)(F.ws + WS_A);
    const float* lng = in[24] + layer * D; const float* lnb = in[25] + layer * D;
    const i32x4* toki = (const i32x4*)(F.ws + WS_TOKI); const f32x2* tokg = (const f32x2*)(F.ws + WS_TOKG);
    const int lane = F.lane;
    float gm[4][8], bt[4][8];
#pragma unroll
    for (int j = 0; j < 4; ++j) { const int c0 = (j * 64 + lane) * 8; const f32x4 g0 = *(const f32x4*)(lng + c0), g1 = *(const f32x4*)(lng + c0 + 4), b0 = *(const f32x4*)(lnb + c0), b1 = *(const f32x4*)(lnb + c0 + 4);
#pragma unroll
        for (int q = 0; q < 4; ++q) { gm[j][q] = g0[q]; gm[j][4 + q] = g1[q]; bt[j][q] = b0[q]; bt[j][4 + q] = b1[q]; } }
    const int gw = F.bx * NWAVES + F.wave, NGW = F.G * NWAVES;
    for (int tok = gw; tok < NTOK; tok += NGW) {
        const i32x4 ti = toki[tok]; const f32x2 tg = tokg[tok];
        const int e0 = ti.x & 255, e1 = (ti.x >> 8) & 255; const size_t p0 = (size_t)(T.sb[e0] + ti.y), p1 = (size_t)(T.sb[e1] + ti.z);
        float x[4][8]; float s = 0.f;
#pragma unroll
        for (int j = 0; j < 4; ++j) { const int c0 = (j * 64 + lane) * 8; const u32x4 h = *(const u32x4*)(H + (size_t)tok * D + c0); const u32x2 y0 = *(const u32x2*)(YB + p0 * D + c0), y1 = *(const u32x2*)(YB + p1 * D + c0);
            float a0[8], a1[8]; unpk4_fp8(y0.x, a0); unpk4_fp8(y0.y, a0 + 4); unpk4_fp8(y1.x, a1); unpk4_fp8(y1.y, a1 + 4);
            const float g0 = tg.x * (1.0f / SC_Y), g1 = tg.y * (1.0f / SC_Y);
#pragma unroll
            for (int q = 0; q < 4; ++q) { x[j][2 * q] = ALPHA * bf_lo(h[q]) + g0 * a0[2 * q] + g1 * a1[2 * q]; x[j][2 * q + 1] = ALPHA * bf_hi(h[q]) + g0 * a0[2 * q + 1] + g1 * a1[2 * q + 1]; s += x[j][2 * q] + x[j][2 * q + 1]; } }
        const float mu = wave_sum(s) * (1.0f / D); float s2 = 0.f;
#pragma unroll
        for (int j = 0; j < 4; ++j)
#pragma unroll
            for (int q = 0; q < 8; ++q) { x[j][q] -= mu; s2 += x[j][q] * x[j][q]; }
        const float rs = 1.0f / sqrtf(wave_sum(s2) * (1.0f / D) + LN_EPS);
#pragma unroll
        for (int j = 0; j < 4; ++j) { const int c0 = (j * 64 + lane) * 8; float o[8];
#pragma unroll
            for (int q = 0; q < 8; ++q) o[q] = x[j][q] * rs * gm[j][q] + bt[j][q];
            if constexpr (FINAL) { *(f32x4*)(out + (size_t)tok * D + c0) = (f32x4){o[0], o[1], o[2], o[3]}; *(f32x4*)(out + (size_t)tok * D + c0 + 4) = (f32x4){o[4], o[5], o[6], o[7]}; }
            else { u32x4 w; w.x = cvt_pk_bf16(o[0], o[1]); w.y = cvt_pk_bf16(o[2], o[3]); w.z = cvt_pk_bf16(o[4], o[5]); w.w = cvt_pk_bf16(o[6], o[7]); *(u32x4*)(H2 + (size_t)tok * D + c0) = w;
                u32x2 w8; w8.x = pk4_fp8(o[0], o[1], o[2], o[3]); w8.y = pk4_fp8(o[4], o[5], o[6], o[7]); *(u32x2*)(F.ws + WS_H8 + (size_t)tok * D + c0) = w8; } }
    }
}

__device__ __forceinline__ void scan_phase(Frame& F, const float* const* in) {
    const float* a_re = in[9]; const float* a_im = in[10]; const float* log_dt = in[11];
    const float* Xend = (const float*)(F.ws + WS_XEND); bf16_t* A2 = (bf16_t*)(F.ws + WS_A2);
    for (int idx = F.bx * NTHR + F.tid; idx < BG * NBATCH * BST; idx += F.G * NTHR) {
        const int p = idx & 63, b = (idx >> 6) & 15, g = idx >> 10;
        const float dt = expf(log_dt[g]); const float zr = a_re[g * 64 + p] * dt * 16.0f, zi = a_im[g * 64 + p] * dt * 16.0f;
        const float mag = expf(zr); float sn, cs; sincosf(zi, &sn, &cs); const float ar = mag * cs, ai = mag * sn;
        float xr = 0.f, xi = 0.f; const size_t row0 = (size_t)g * 2048 + b * 128;
#pragma unroll 8
        for (int j = 0; j < 128; ++j) { const size_t row = row0 + j; const float er = Xend[row * 128 + p], ei = Xend[row * 128 + 64 + p];
            A2[row * 384 + 256 + p] = (bf16_t)f2bf(xr); A2[row * 384 + 320 + p] = (bf16_t)f2bf(xi);
            const float nr = ar * xr - ai * xi + er, ni = ar * xi + ai * xr + ei; xr = nr; xi = ni; }
    }
}

__device__ __forceinline__ void convert_experts(Frame& F, const float* const* in, int layer) {
    int itbase = 0; __syncthreads();
    transpose_job_f8(F, in[22] + (size_t)layer * 16 * 2048 * 2048, F.ws + (layer == 0 ? WS_EIN : WS_EIN1), 16, 2048, 2048, true, SC_WIN, itbase);
    transpose_job_f8(F, in[23] + (size_t)layer * 16 * 1024 * 2048, F.ws + (layer == 0 ? WS_EOUT : WS_EOUT1), 16, 1024, 2048, false, SC_WOUT, itbase);
    __syncthreads();
}
#ifndef PHASE_MASK
#define PHASE_MASK 0x1ffff
#endif
template <int LAYER>
__device__ __forceinline__ void moe_block(Frame& F, const Args& args, const XcdBarrier& bar) {
    const int lo = args.ph_lo, hi = args.ph_hi; const float* const* in = args.in; unsigned char* ws = args.ws;
    constexpr int pb = LAYER == 0 ? 4 : 13;
#define IN(k) (((PHASE_MASK >> (k)) & 1) && lo <= (k) && (k) < hi)
#define SEAM(k) do { if (IN(k) && IN((k) + 1)) xcd_barrier(bar); } while (0)
    if (IN(pb)) { ln_route_phase(F, in, LAYER); } SEAM(pb);
    if (IN(pb + 1)) { MoeTab T = moe_tables(F, LAYER);
        GemmM1 g; g.nostore = args.flags & 1; g.init_bytes(2048, 2048, F.G, F.bx); g.H8 = ws + WS_H8; g.Bt = ws + (LAYER == 0 ? WS_EIN : WS_EIN1); g.ACT = ws + WS_A; g.T = T;
        LAS int* rows = (LAS int*)(F.lds + LDS_ROWS); g.rows = rows;
        const int* rowlist = (const int*)(ws + WS_ROWLIST);
        { pg8::Unit u; for (int ui = 0; ui < 10 && g.next(ui, u); ++ui) { if (F.tid < 256) { const int slot = u.w * 256 + F.tid; rows[ui * 256 + F.tid] = (slot < __builtin_amdgcn_readfirstlane(T.cnt[u.z])) ? rowlist[u.z * NTOK + slot] : 0; } } }
        __syncthreads();
        if constexpr (LAYER == 0) { if (F.bx & 1) convert_experts(F, in, 1); }
        pg8::gemm_phase(F.lds, g);
        if constexpr (LAYER == 0) { if (!(F.bx & 1)) convert_experts(F, in, 1); } } SEAM(pb + 1);
    if (IN(pb + 2)) { MoeTab T = moe_tables(F, LAYER);
        GemmM2 g; g.nostore = args.flags & 1; g.init_bytes(1024, 1024, F.G, F.bx); g.ACT = ws + WS_A; g.Bt = ws + (LAYER == 0 ? WS_EOUT : WS_EOUT1); g.YB = ws + WS_B; g.T = T; g.hstepB = (size_t)8 * g.ldb2;
        pg8::gemm_phase(F.lds, g); } SEAM(pb + 2);
    if (IN(pb + 3)) { MoeTab T = moe_tables(F, LAYER);
        if constexpr (LAYER == 0) { ln2_phase<false>(F, in, 0, T, nullptr); }
        else ln2_phase<true>(F, in, 1, T, args.out); }
#undef IN
#undef SEAM
}

constexpr int N_PHASES = 17;
__global__ void __launch_bounds__(NTHR, 2) fwd_kernel(Args args) {
    extern __shared__ __attribute__((aligned(16))) unsigned char lds_raw[];
    Frame F; F.lds = (LAS unsigned char*)lds_raw; F.ws = args.ws; F.ctl = (unsigned*)(args.ws + WS_CTL);
    F.tid = threadIdx.x; F.lane = F.tid & 63; F.wave = __builtin_amdgcn_readfirstlane(F.tid >> 6); F.G = gridDim.x; F.bx = blockIdx.x;
    if (F.tid < 4) ((LAS unsigned*)(F.lds + LDS_BARW))[F.tid] = 0u;
    __syncthreads();
    XcdBarrier bar; bar.bar = F.ctl + CW_BAR; bar.x = 0; bar.st = nullptr;
    const bool one = (args.ph_hi - args.ph_lo) > 1;
    if (one) bar = xcd_barrier_post(F.ctl + CW_BAR, (volatile LAS unsigned*)(F.lds + LDS_BARW));
    const int lo = args.ph_lo, hi = args.ph_hi;
#ifndef PHASE_MASK
#define PHASE_MASK 0x1ffff
#endif
#define IN(k) (((PHASE_MASK >> (k)) & 1) && lo <= (k) && (k) < hi)
#define SEAM(k) do { if (IN(k) && IN((k) + 1)) xcd_barrier(bar); } while (0)
    const float* const* in = args.in;
    unsigned char* ws = args.ws;

    if (IN(0)) { p0_prologue(F, in); } SEAM(0);
    if (IN(1)) { GemmG1 g; g.nostore = args.flags & 1; g.init_bytes(2048, 2048, F.G, F.bx); g.A = ws + WS_X8; g.Bt = ws + WS_WIN; g.O = ws + WS_B; g.bias = in[2]; g.hstepB = (size_t)8 * g.ldb2;
        if (F.bx & 1) convert_experts(F, in, 0);
        pg8::gemm_phase(F.lds, g);
        if (!(F.bx & 1)) convert_experts(F, in, 0); } SEAM(1);
    if (IN(2)) { g2_phase(F, in); } SEAM(2);
    if (IN(3)) { GemmG3 g; g.nostore = args.flags & 1; g.init_bytes(2048, 2048, F.G, F.bx); g.A = ws + WS_H8; g.Bt = ws + WS_WOUT; g.Z = (bf16_t*)(ws + WS_C); g.R = (const bf16_t*)(ws + WS_A); g.hstepB = (size_t)8 * g.ldb2;
        pg8::gemm_phase(F.lds, g); } SEAM(3);
    moe_block<0>(F, args, bar);
    SEAM(7);
    if (IN(8)) { GemmS1 g; g.nostore = args.flags & 1; g.init_bytes(2048, 2048, F.G, F.bx); g.A = ws + WS_H8; g.Bt = ws + WS_BWIN; g.A2 = (bf16_t*)(ws + WS_A2); g.hstepB = (size_t)8 * g.ldb2;
        pg8::gemm_phase(F.lds, g); } SEAM(8);
    if (IN(9)) { GemmS2 g; g.nostore = args.flags & 1; g.init_plain(256, 384, F.G, F.bx); g.A2 = (const bf16_t*)(ws + WS_A2); g.Et = (const bf16_t*)(ws + WS_SSME); g.Xend = (float*)(ws + WS_XEND);
        pg8::gemm_phase(F.lds, g); } SEAM(9);
    if (IN(10)) { scan_phase(F, in); } SEAM(10);
    if (IN(11)) { GemmS4 g; g.nostore = args.flags & 1; g.init_plain(384, 384, F.G, F.bx); g.A2 = (const bf16_t*)(ws + WS_A2); g.Bs = (const bf16_t*)(ws + WS_SSMB); g.Y = ws + WS_Y; g.hstepB = (size_t)8 * g.ldb2;
        pg8::gemm_phase(F.lds, g); } SEAM(11);
    if (IN(12)) { GemmS5 g; g.nostore = args.flags & 1; g.init_bytes(1024, 0, F.G, F.bx); g.kstepA = 8u * 2048u * 256u; g.Y = ws + WS_Y; g.Bt = ws + WS_BWOUT; g.Z = (bf16_t*)(ws + WS_C); g.R = (const bf16_t*)(ws + WS_A);
        pg8::gemm_phase(F.lds, g); } SEAM(12);
    moe_block<1>(F, args, bar);
#undef IN
#undef SEAM
}

extern "C" void kernel_launch(void* const* d_in, const int* in_sizes, int n_in, void* d_out, int out_size, void* d_ws, size_t ws_size, hipStream_t stream) {
    static int grid = 0;
    if (grid == 0) {
        if (n_in != 26 || in_sizes[0] != NTOK * D || out_size != NTOK * D || ws_size < WS_END) { fprintf(stderr, "kernel_launch: unexpected problem (n_in %d, ws %zu)\n", n_in, ws_size); grid = -1; return; }
        int dev = 0, cus = 0, per_cu = 0;
        if (hipGetDevice(&dev) != hipSuccess || hipDeviceGetAttribute(&cus, hipDeviceAttributeMultiprocessorCount, dev) != hipSuccess) { grid = -1; return; }
        if (hipFuncSetAttribute((const void*)fwd_kernel, hipFuncAttributeMaxDynamicSharedMemorySize, LDS_BYTES) != hipSuccess) { fprintf(stderr, "kernel_launch: hipFuncSetAttribute failed\n"); grid = -1; return; }
        if (hipOccupancyMaxActiveBlocksPerMultiprocessor(&per_cu, (const void*)fwd_kernel, NTHR, LDS_BYTES) != hipSuccess || per_cu < 1) fprintf(stderr, "kernel_launch: occupancy query reports %d\n", per_cu);
        (void)hipGetLastError();
        grid = cus;
        if (grid != 256) fprintf(stderr, "kernel_launch: %d CUs (built for 256)\n", grid);
    }
    if (grid < 0) return;
    if (hipMemsetAsync((char*)d_ws + WS_CTL, 0, CTL_ZERO_BYTES, stream) != hipSuccess) return;
    Args a{};
    for (int i = 0; i < 26; ++i) a.in[i] = (const float*)d_in[i];
    a.out = (float*)d_out; a.ws = (unsigned char*)d_ws;
#if MK_N_LAUNCHES == 1
    a.ph_lo = 0; a.ph_hi = N_PHASES;
    hipLaunchKernelGGL(fwd_kernel, dim3(grid), dim3(NTHR), LDS_BYTES, stream, a);
#else
    for (int p = 0; p < N_PHASES; ++p) { a.ph_lo = p; a.ph_hi = p + 1; for (int r = 0; r < 1 + ((REPEAT_MASK >> p) & 1); ++r) { a.flags = (PROBE_NOSTORE && r == 0 && ((REPEAT_MASK >> p) & 1)) ? 1 : 0; hipLaunchKernelGGL(fwd_kernel, dim3(grid), dim3(NTHR), LDS_BYTES, stream, a); } }
#endif
}
```

```cpp
#include <hip/hip_runtime.h>
#include <cstdio>
#include <cstdint>

#ifndef PROBE_NOSTORE
#define PROBE_NOSTORE 0
#endif
#ifndef REPEAT_MASK
#define REPEAT_MASK 0x0
#endif
#ifndef MK_N_LAUNCHES
#define MK_N_LAUNCHES 1
#endif

#define GAS __attribute__((address_space(1)))
#define LAS __attribute__((address_space(3)))
typedef unsigned short bf16_t;
typedef short bf16x8 __attribute__((ext_vector_type(8)));
typedef float f32x4 __attribute__((ext_vector_type(4)));
typedef float f32x2 __attribute__((ext_vector_type(2)));
typedef unsigned u32x4 __attribute__((ext_vector_type(4)));
typedef unsigned u32x2 __attribute__((ext_vector_type(2)));
typedef int i32x4 __attribute__((ext_vector_type(4)));
typedef int i32x8 __attribute__((ext_vector_type(8)));

constexpr int D = 2048, NTOK = 32768, SEQ = 2048, NBATCH = 16;
constexpr int CHUNK = 128, AG = 8, AGD = 256;
constexpr int BW = 1024, BG = 64, BCH = 16, BST = 64;
constexpr int NE = 16, DFF = 1024;
constexpr float ALPHA = 1.41421356237f, LN_EPS = 1e-5f;
constexpr int NWAVES = 8, NTHR = 512;

constexpr size_t MiB = 1u << 20;
constexpr size_t WS_CTL = 0, CTL_ZERO_BYTES = 1 * MiB;
constexpr size_t WS_ROWLIST = 1 * MiB;
constexpr size_t WS_TOKI = 3 * MiB;
constexpr size_t WS_TOKG = 3 * MiB + 512 * 1024;
constexpr size_t WS_WTRIL = 3 * MiB + 768 * 1024;
constexpr size_t WS_SSMB = 4 * MiB;
constexpr size_t WS_SSME = 16 * MiB;
constexpr size_t WS_RWF = 24 * MiB;
constexpr size_t WS_WIN = 32 * MiB;
constexpr size_t WS_WOUT = 48 * MiB;
constexpr size_t WS_BWIN = 56 * MiB;
constexpr size_t WS_BWOUT = 60 * MiB;
constexpr size_t WS_EIN = 72 * MiB;
constexpr size_t WS_H8 = 136 * MiB;
constexpr size_t WS_EOUT = 200 * MiB;
constexpr size_t WS_A = 264 * MiB;
constexpr size_t WS_B = 408 * MiB;
constexpr size_t WS_C = 664 * MiB;
constexpr size_t WS_D = 792 * MiB;
constexpr size_t WS_EIN1 = 920 * MiB;
constexpr size_t WS_EOUT1 = 984 * MiB;
constexpr size_t WS_END = 1016 * MiB;
constexpr size_t WS_X8 = WS_D;
constexpr size_t WS_A2 = WS_B, WS_XEND = WS_B + 96 * MiB, WS_Y = WS_B + 160 * MiB;
constexpr int ACT_ROWS = 65536 + 16 * 256;
constexpr int CW_BAR = 4096;
constexpr int CW_XQ = 16384 + 1024;
constexpr int CW_CNT = 16384;

constexpr int RING_BYTES = 131072;
constexpr int LDS_ROWS = RING_BYTES;
constexpr int LDS_MOE = LDS_ROWS + 10 * 1024;
constexpr int LDS_BARW = LDS_MOE + 512;
constexpr int LDS_BYTES = 147456;

__device__ __forceinline__ unsigned cvt_pk_bf16(float lo, float hi) { unsigned r; asm("v_cvt_pk_bf16_f32 %0, %1, %2" : "=v"(r) : "v"(lo), "v"(hi)); return r; }
__device__ __forceinline__ float bf_lo(unsigned w) { return __uint_as_float(w << 16); }
__device__ __forceinline__ float bf_hi(unsigned w) { return __uint_as_float(w & 0xffff0000u); }
__device__ __forceinline__ unsigned f2bf(float f) { unsigned u = __float_as_uint(f); return (u + 0x7fffu + ((u >> 16) & 1u)) >> 16; }
__device__ __forceinline__ float wave_sum(float v) {
#define WS_DPP(x, ctrl, rmask) __builtin_bit_cast(float, __builtin_amdgcn_update_dpp(0, __builtin_bit_cast(int, (x)), (ctrl), (rmask), 0xF, false))
    v += WS_DPP(v, 0xB1, 0xF);
    v += WS_DPP(v, 0x4E, 0xF);
    v += WS_DPP(v, 0x141, 0xF);
    v += WS_DPP(v, 0x140, 0xF);
    v += WS_DPP(v, 0x142, 0xA);
    v += WS_DPP(v, 0x143, 0xC);
#undef WS_DPP
    return __builtin_bit_cast(float, __builtin_amdgcn_readlane(__builtin_bit_cast(int, v), 63));
}
__device__ __forceinline__ f32x2 gelu2(f32x2 x) {
    f32x2 xc; xc.x = __builtin_amdgcn_fmed3f(x.x, -3.5f, 3.5f); xc.y = __builtin_amdgcn_fmed3f(x.y, -3.5f, 3.5f);
    const f32x2 u = xc * xc;
    f32x2 p = u * (-8.701348406248144e-07f) + 4.0298804378835484e-05f; p = p * u + (-0.0007917149341665208f); p = p * u + 0.00885754730552435f; p = p * u + (-0.06504099816083908f); p = p * u + 0.3982582986354828f;
    return x * (xc * p + 0.5f);
}
__device__ __forceinline__ f32x2 gelu2x8(f32x2 x) {
    f32x2 xc; xc.x = __builtin_amdgcn_fmed3f(x.x, -3.5f, 3.5f); xc.y = __builtin_amdgcn_fmed3f(x.y, -3.5f, 3.5f);
    const f32x2 u = xc * xc;
    f32x2 p = u * (8.0f * -8.701348406248144e-07f) + (8.0f * 4.0298804378835484e-05f); p = p * u + (8.0f * -0.0007917149341665208f); p = p * u + (8.0f * 0.00885754730552435f); p = p * u + (8.0f * -0.06504099816083908f); p = p * u + (8.0f * 0.3982582986354828f);
    return x * (xc * p + 4.0f);
}
__device__ __forceinline__ f32x2 sig2(f32x2 g) {
    f32x2 gc; gc.x = __builtin_amdgcn_fmed3f(g.x, -7.0f, 7.0f); gc.y = __builtin_amdgcn_fmed3f(g.y, -7.0f, 7.0f);
    const f32x2 u = gc * gc;
    f32x2 p = u * 9.362564196147005e-11f + (-1.7167415933272423e-08f); p = p * u + 1.283512915506435e-06f; p = p * u + (-5.098102701595053e-05f); p = p * u + 0.0011952189961448312f; p = p * u + (-0.01824037730693817f); p = p * u + 0.247629314661026f;
    return gc * p + 0.5f;
}
__device__ __forceinline__ unsigned pk2(f32x2 v) { return cvt_pk_bf16(v.x, v.y); }
__device__ __forceinline__ unsigned pk4_fp8(float a, float b, float c, float d) {
    int w = 0;
    w = __builtin_amdgcn_cvt_pk_fp8_f32(__builtin_amdgcn_fmed3f(a, -448.f, 448.f), __builtin_amdgcn_fmed3f(b, -448.f, 448.f), w, false);
    w = __builtin_amdgcn_cvt_pk_fp8_f32(__builtin_amdgcn_fmed3f(c, -448.f, 448.f), __builtin_amdgcn_fmed3f(d, -448.f, 448.f), w, true);
    return (unsigned)w;
}
__device__ __forceinline__ void unpk4_fp8(unsigned w, float* o) { const f32x2 a = __builtin_amdgcn_cvt_pk_f32_fp8((int)w, false), b = __builtin_amdgcn_cvt_pk_f32_fp8((int)w, true); o[0] = a.x; o[1] = a.y; o[2] = b.x; o[3] = b.y; }
__device__ __forceinline__ unsigned pk4_fp8_nc(float a, float b, float c, float d) { int w = 0; w = __builtin_amdgcn_cvt_pk_fp8_f32(a, b, w, false); w = __builtin_amdgcn_cvt_pk_fp8_f32(c, d, w, true); return (unsigned)w; }
constexpr float SC_WIN = 32.0f, SC_WOUT = 64.0f, SC_ACT = 8.0f, SC_Y = 16.0f, SC_BW = 32.0f, SC_YS = 8.0f, SC_AWO = 64.0f, SC_P = 4.0f, SC_AWI = 32.0f, SC_UV = 8.0f, SC_Z = 16.0f;
#define LO2(v) ((f32x2){(v)[0], (v)[1]})
#define HI2(v) ((f32x2){(v)[2], (v)[3]})

#define XB_TMO      128
#define XB_XCNT(j)  (256  + 64 * (j))
#define XB_XSUB(j)  (1280 + 64 * (j))
#define XB_XGEN(j)  (2304 + 64 * (j))
#define XB_TOP      3328
#define XB_TOPGEN   3392
#define XCD_BAR_WORDS 3456
#define XB_SPIN_CAP (1u << 18)
__device__ __forceinline__ unsigned xb_ld(unsigned* p)              { return __hip_atomic_load(p, __ATOMIC_RELAXED, __HIP_MEMORY_SCOPE_AGENT); }
__device__ __forceinline__ unsigned xb_add(unsigned* p, unsigned v) { return __hip_atomic_fetch_add(p, v, __ATOMIC_RELAXED, __HIP_MEMORY_SCOPE_AGENT); }
__device__ __forceinline__ unsigned xb_xcc_id() { return (unsigned)__builtin_amdgcn_s_getreg((3 << 11) | 20) & 0xFu; }
#define XB_SPIN(cond, bar) do { unsigned _sp = 0; while (cond) { __builtin_amdgcn_s_sleep(1); \
    if ((++_sp & 255u) == 0u) { if (xb_ld(&(bar)[XB_TMO])) break; if (_sp > XB_SPIN_CAP) { atomicAdd(&(bar)[XB_TMO], 1u); break; } } } } while (0)
struct XcdBarrier { unsigned* bar; unsigned x; volatile LAS unsigned* st; };
__device__ __forceinline__ XcdBarrier xcd_barrier_post(unsigned* bar, volatile LAS unsigned* st) {
    XcdBarrier b; b.bar = bar; b.x = xb_xcc_id(); b.st = st;
    if (threadIdx.x == 0) (void)xb_add(&bar[XB_XCNT(b.x)], 1u);
    return b;
}
__device__ __forceinline__ void xcd_barrier_complete(unsigned* bar, unsigned x, unsigned& nloc, unsigned& nx) {
    const unsigned G = gridDim.x * gridDim.y * gridDim.z;
    unsigned sum, cnt, mine, sp = 0u;
    for (;;) {
        sum = 0u; cnt = 0u; mine = 0u;
#pragma unroll
        for (unsigned j = 0; j < 16; ++j) { const unsigned c = xb_ld(&bar[XB_XCNT(j)]); sum += c; cnt += (c > 0u) ? 1u : 0u; mine = (j == x) ? c : mine; }
        if (sum == G) break;
        __builtin_amdgcn_s_sleep(1);
        if ((++sp & 255u) == 0u) { if (xb_ld(&bar[XB_TMO])) break; if (sp > XB_SPIN_CAP) { atomicAdd(&bar[XB_TMO], 1u); break; } }
    }
    nloc = mine > 0u ? mine : 1u; nx = cnt > 0u ? cnt : 1u;
}
__device__ __forceinline__ void xcd_barrier(const XcdBarrier& b) {
    asm volatile("s_waitcnt vmcnt(0)" ::: "memory");
    __syncthreads();
    if (threadIdx.x == 0) {
        unsigned* bar = b.bar;
        __builtin_amdgcn_s_waitcnt(0);
        unsigned nloc = b.st[0], nx = b.st[1];
        if (nloc == 0u) { xcd_barrier_complete(bar, b.x, nloc, nx); b.st[0] = nloc; b.st[1] = nx; }
        const unsigned old = xb_add(&bar[XB_XSUB(b.x)], 1u);
        const unsigned gen = old / nloc;
        if (old + 1u == (gen + 1u) * nloc) {
            __builtin_amdgcn_fence(__ATOMIC_RELEASE, "agent");
            asm volatile("s_waitcnt vmcnt(0)" ::: "memory");
            (void)xb_add(&bar[XB_TOP], 1u);
        }
        XB_SPIN(xb_ld(&bar[XB_TOP]) < (gen + 1u) * nx, bar);
        __builtin_amdgcn_fence(__ATOMIC_ACQUIRE, "agent");
        asm volatile("s_waitcnt vmcnt(0)" ::: "memory");
    }
    __syncthreads();
}

namespace pg8 {
constexpr int BM = 256, BK = 64, HALF = 128, HTB = HALF * BK * 2, STAGE_BYTES = 8 * HTB, NXCD = 8, WGM = 8;
__device__ __forceinline__ int lds_byte(int r, int c) { const int st = (r >> 4) * 2 + (c >> 5), rr = r & 15, cc = c & 31, ob = rr * 64 + cc * 2; return st * 1024 + (ob ^ (((ob >> 9) & 1) << 5)); }
__device__ __forceinline__ void stage_rc(int b, int& R, int& C) { const int st = b / 1024, sb = b % 1024, swz = sb ^ (((sb >> 9) & 1) << 5); R = (st >> 1) * 16 + swz / 64; C = (st & 1) * 32 + (swz % 64) / 2; }
__device__ __forceinline__ int perm32(int rho) { const int n = rho >> 4, i = rho & 15; return 8 * (i >> 2) + 4 * n + (i & 3); }

struct Unit { const char* a; const char* b; int x, y, z, w; };
typedef f32x4 Acc[2][2][4][2];

__device__ __forceinline__ bool static_unit(long L, int nM, int nN, int& pm, int& pn) {
    const int nwg = nM * nN; if (L >= nwg) return false;
    int wgid = (int)L; { const int q = nwg / NXCD, r = nwg % NXCD, xcd = wgid % NXCD, off = wgid / NXCD; wgid = (xcd < r ? xcd * (q + 1) : r * (q + 1) + (xcd - r) * q) + off; }
    const int nig = WGM * nN, gid = wgid / nig, fm = gid * WGM, gsz = (nM - fm) < WGM ? (nM - fm) : WGM;
    pm = fm + ((wgid % nig) % gsz); pn = (wgid % nig) / gsz; return true;
}

template <class G>
__device__ __forceinline__ void gemm_phase(LAS unsigned char* lds, const G& g) {
    const int tid = threadIdx.x, wid = __builtin_amdgcn_readfirstlane(tid >> 6), lane = tid & 63, wr = wid >> 2, wc = wid & 3, fr = lane & 15, fq = lane >> 4;
    const int nt = g.nt;
    unsigned voffB[2], vA0[2], vA1[2], nA0[2], nA1[2]; int Rl[2], Cl[2];
#pragma unroll
    for (int i = 0; i < 2; ++i) { int R, C; stage_rc(tid * 16 + i * 8192, R, C); const int Rb = (G::PERMK == 2) ? (64 * (R >> 5) + 16 * ((R & 15) >> 2) + 4 * ((R >> 4) & 1) + (R & 3)) : (G::PERMK == 1) ? ((R & ~31) + perm32(R & 31)) : R;
        Rl[i] = R; Cl[i] = C; voffB[i] = g.voffB(Rb, C); }
    const size_t kstepA = g.kstepA, kstepB = g.kstepB, hstepB = g.hstepB;
    const unsigned ldsw = (unsigned)wid * 1024u;
    const int aoff = lds_byte(wr * 64 + fr, fq * 8), boff = lds_byte(wc * 32 + fr, fq * 8);
#define PG8_SA(b, h) (((b) * 2 + (h)) * HTB)
#define PG8_SB(b, h) ((4 + (b) * 2 + (h)) * HTB)
#define PG8_STAGE(bufoff, gbase, voff) do { _Pragma("unroll") for (int _i = 0; _i < 2; ++_i) \
        __builtin_amdgcn_global_load_lds((const unsigned*)((const char*)(gbase) + (voff)[_i]), (LAS unsigned*)(lds + (bufoff) + ldsw + _i * 8192), 16, 0, 0); } while (0)
#define PG8_LDA(dst, b, h) do { _Pragma("unroll") for (int m = 0; m < 4; ++m) _Pragma("unroll") for (int k = 0; k < 2; ++k) dst[m][k] = *(const LAS i32x4*)(lds + PG8_SA(b, h) + aoff + m * 2048 + k * 1024); } while (0)
#define PG8_LDB(dst, b, h) do { _Pragma("unroll") for (int n = 0; n < 2; ++n) _Pragma("unroll") for (int k = 0; k < 2; ++k) dst[n][k] = *(const LAS i32x4*)(lds + PG8_SB(b, h) + boff + n * 2048 + k * 1024); } while (0)
#define PG8_CAT(f) __builtin_shufflevector((f)[0], (f)[1], 0, 1, 2, 3, 4, 5, 6, 7)
#define PG8_MMA(ai, bj, At, Bt) do { __builtin_amdgcn_s_setprio(1); \
        if constexpr (G::FP8) { _Pragma("unroll") for (int m = 0; m < 4; ++m) _Pragma("unroll") for (int n = 0; n < 2; ++n) \
            asm volatile("v_mfma_scale_f32_16x16x128_f8f6f4 %0, %1, %2, %0, %3, %3 op_sel_hi:[0,0,0]" : "+v"(acc[ai][bj][m][n]) : "v"(PG8_CAT(Bt[n])), "v"(PG8_CAT(At[m])), "v"(sc1)); } \
        else { _Pragma("unroll") for (int m = 0; m < 4; ++m) _Pragma("unroll") for (int n = 0; n < 2; ++n) _Pragma("unroll") for (int k = 0; k < 2; ++k) \
            acc[ai][bj][m][n] = __builtin_amdgcn_mfma_f32_16x16x32_bf16(__builtin_bit_cast(bf16x8, Bt[n][k]), __builtin_bit_cast(bf16x8, At[m][k]), acc[ai][bj][m][n], 0, 0, 0); } \
        __builtin_amdgcn_s_setprio(0); } while (0)
#define PG8_ZERO(ai) do { _Pragma("unroll") for (int b = 0; b < 2; ++b) _Pragma("unroll") for (int m = 0; m < 4; ++m) _Pragma("unroll") for (int n = 0; n < 2; ++n) acc[ai][b][m][n] = (f32x4){0.f, 0.f, 0.f, 0.f}; } while (0)
#define PG8_WAIT_V(n) asm volatile("s_waitcnt vmcnt(" #n ")" ::: "memory")
#define PG8_WAIT_L(n) asm volatile("s_waitcnt lgkmcnt(" #n ")" ::: "memory")
#define PG8_BAR __builtin_amdgcn_s_barrier()
#define PG8_SCHED __builtin_amdgcn_sched_barrier(0)
    Unit cur, nxt; int ui = 0;
    if (!g.next(0, cur)) return;
    Acc acc;
#pragma unroll
    for (int a = 0; a < 2; ++a)
#pragma unroll
        for (int b = 0; b < 2; ++b)
#pragma unroll
            for (int m = 0; m < 4; ++m)
#pragma unroll
                for (int n = 0; n < 2; ++n) acc[a][b][m][n] = (f32x4){0.f, 0.f, 0.f, 0.f};
    i32x4 At[4][2], B0[2][2], B1[2][2];
    const int sc1 = 0x7f7f7f7f;
    const char* cA = cur.a; const char* cB = cur.b;
#pragma unroll
    for (int i = 0; i < 2; ++i) {
        if constexpr (G::GATHER) { vA0[i] = g.gatherA(0, Rl[i], Cl[i], 0); vA1[i] = g.gatherA(0, Rl[i], Cl[i], 1); }
        else { vA0[i] = g.voffA(Rl[i], Cl[i], 0); vA1[i] = g.voffA(Rl[i], Cl[i], 1); }
        nA0[i] = vA0[i]; nA1[i] = vA1[i];
    }
    PG8_STAGE(PG8_SB(0, 0), cB, voffB); PG8_STAGE(PG8_SB(0, 1), cB + hstepB, voffB); PG8_STAGE(PG8_SA(0, 0), cA, vA0); PG8_STAGE(PG8_SA(0, 1), cA, vA1);
    if (wr == 1) PG8_BAR;
    PG8_WAIT_V(2); PG8_BAR;
    PG8_STAGE(PG8_SB(1, 0), cB + kstepB, voffB); PG8_STAGE(PG8_SA(1, 0), cA + kstepA, vA0); PG8_STAGE(PG8_SB(1, 1), cB + hstepB + kstepB, voffB);
    PG8_WAIT_V(6); PG8_BAR;
    for (;;) {
        const bool has_next = g.next(ui + 1, nxt);
        const char* nA = has_next ? nxt.a : cA; const char* nB = has_next ? nxt.b : cB;
        for (int t = 0; t < nt; t += 2) {
            const bool last = (t == nt - 2);
            const char* a1 = cA + (size_t)(t + 1) * kstepA;
            const char* a2 = last ? nA : cA + (size_t)(t + 2) * kstepA; const char* b2 = last ? nB : cB + (size_t)(t + 2) * kstepB;
            const char* a3 = a2 + kstepA; const char* b3 = b2 + kstepB;
            unsigned s0[2], s1[2];
            if constexpr (G::GATHER) {
                if (last && has_next) {
#pragma unroll
                    for (int i = 0; i < 2; ++i) { nA0[i] = g.gatherA(ui + 1, Rl[i], Cl[i], 0); nA1[i] = g.gatherA(ui + 1, Rl[i], Cl[i], 1); }
                }
#pragma unroll
                for (int i = 0; i < 2; ++i) { s0[i] = last ? nA0[i] : vA0[i]; s1[i] = last ? nA1[i] : vA1[i]; }
            } else {
#pragma unroll
                for (int i = 0; i < 2; ++i) { s0[i] = vA0[i]; s1[i] = vA1[i]; }
            }
            PG8_LDB(B0, 0, 0); PG8_LDB(B1, 0, 1); PG8_SCHED; PG8_LDA(At, 0, 0); PG8_STAGE(PG8_SA(1, 1), a1, vA1);
            if constexpr (G::FP8) if (t == 0) PG8_ZERO(0);
            PG8_WAIT_V(8); PG8_WAIT_L(0); PG8_BAR; PG8_MMA(0, 0, At, B0); PG8_MMA(0, 1, At, B1); PG8_BAR; PG8_SCHED;
            PG8_LDA(At, 0, 1); PG8_STAGE(PG8_SB(0, 0), b2, voffB); PG8_STAGE(PG8_SB(0, 1), b2 + hstepB, voffB); PG8_STAGE(PG8_SA(0, 0), a2, s0);
            if constexpr (G::FP8) if (t == 0) PG8_ZERO(1);
            PG8_WAIT_V(8); PG8_WAIT_L(0); PG8_BAR; PG8_MMA(1, 0, At, B0); PG8_MMA(1, 1, At, B1); PG8_BAR; PG8_SCHED;
            PG8_LDB(B0, 1, 0); PG8_LDB(B1, 1, 1); PG8_SCHED; PG8_LDA(At, 1, 0); PG8_STAGE(PG8_SA(0, 1), a2, s1);
            PG8_WAIT_V(8); PG8_WAIT_L(0); PG8_BAR; PG8_MMA(0, 0, At, B0); PG8_MMA(0, 1, At, B1); PG8_BAR; PG8_SCHED;
            PG8_LDA(At, 1, 1); PG8_STAGE(PG8_SB(1, 0), b3, voffB); PG8_STAGE(PG8_SB(1, 1), b3 + hstepB, voffB); PG8_STAGE(PG8_SA(1, 0), a3, s0);
            PG8_WAIT_V(8); PG8_WAIT_L(0); PG8_BAR; PG8_MMA(1, 0, At, B0); PG8_MMA(1, 1, At, B1); PG8_BAR; PG8_SCHED;
        }
        if (wr == 0) PG8_BAR;
        if constexpr (G::FP8) asm volatile("s_nop 15\n\ts_nop 15\n\ts_nop 15" ::: "memory");
        if (!g.nostore) g.epi(acc, cur, wr, wc, fr, fq);
        if (!has_next) break;
        if constexpr (!G::FP8) { PG8_ZERO(0); PG8_ZERO(1); }
        cur = nxt; cA = nA; cB = nB; ++ui;
#pragma unroll
        for (int i = 0; i < 2; ++i) { vA0[i] = nA0[i]; vA1[i] = nA1[i]; }
        if (wr == 1) PG8_BAR;
    }
    PG8_WAIT_V(0);
    PG8_BAR;
#undef PG8_SA
#undef PG8_SB
#undef PG8_STAGE
#undef PG8_LDA
#undef PG8_LDB
#undef PG8_MMA
#undef PG8_CAT
#undef PG8_ZERO
#undef PG8_WAIT_V
#undef PG8_WAIT_L
#undef PG8_BAR
#undef PG8_SCHED
}
}

struct GemmBase {
    static constexpr bool GATHER = false, FP8 = false; static constexpr int PERMK = 1;
    int nt; unsigned kstepA, kstepB; size_t hstepB; int G, c; int nostore = 0;
    unsigned lda2, hstepA, ldb2;
    __device__ __forceinline__ unsigned voffA(int R, int C, int h) const { return (unsigned)R * lda2 + (unsigned)C * 2u + (unsigned)h * hstepA; }
    __device__ __forceinline__ unsigned voffB(int Rb, int C) const { return (unsigned)Rb * ldb2 + (unsigned)C * 2u; }
    __device__ __forceinline__ unsigned gatherA(int, int, int, int) const { return 0u; }
    __device__ __forceinline__ void init_bytes(int Kbytes, int lda_bytes, int G_, int c_) {
        nt = Kbytes / 128; kstepA = 128u; kstepB = 128u; ldb2 = (unsigned)Kbytes; hstepB = (size_t)128 * Kbytes; lda2 = (unsigned)lda_bytes; hstepA = 128u * lda2; G = G_; c = c_; }
    __device__ __forceinline__ void init_plain(int K, int lda_elems, int G_, int c_) {
        nt = K / 64; kstepA = 128u; kstepB = 128u; ldb2 = (unsigned)K * 2u; hstepB = (size_t)128 * K * 2; lda2 = (unsigned)lda_elems * 2u; hstepA = 128u * lda2; G = G_; c = c_; }
};

struct GemmG1 : GemmBase {
    static constexpr bool FP8 = true; static constexpr int PERMK = 2;
    const unsigned char* A; const unsigned char* Bt; unsigned char* O; const float* bias;
    __device__ __forceinline__ bool next(int i, pg8::Unit& u) const { int pm, pn; if (!pg8::static_unit((long)i * G + c, NTOK / 256, 16, pm, pn)) return false;
        u.a = (const char*)A + (size_t)pm * 256 * D; u.b = (const char*)Bt + (size_t)pn * 256 * D; u.x = pm; u.y = pn; return true; }
    __device__ __forceinline__ void epi(const pg8::Acc& acc, const pg8::Unit& u, int wr, int wc, int fr, int fq) const {
        const int row0 = u.x * 256 + wr * 64 + fr, col0 = u.y * 256 + wc * 64 + 16 * fq;
        constexpr float SA = 1.0f / SC_AWI;
        f32x4 bv[2][2];
#pragma unroll
        for (int bj = 0; bj < 2; ++bj)
#pragma unroll
            for (int n = 0; n < 2; ++n) bv[bj][n] = *(const f32x4*)(bias + col0 + 8 * bj + 4 * n);
#pragma unroll
        for (int ai = 0; ai < 2; ++ai)
#pragma unroll
            for (int m = 0; m < 4; ++m) { u32x4 w;
#pragma unroll
                for (int bj = 0; bj < 2; ++bj) { const f32x4 v0 = acc[ai][bj][m][0] * SA + bv[bj][0], v1 = acc[ai][bj][m][1] * SA + bv[bj][1];
                    static_assert(SC_UV == 8.0f, "gelu2x8"); const f32x2 r0 = gelu2x8(LO2(v0)), r1 = gelu2x8(HI2(v0)), r2 = gelu2x8(LO2(v1)), r3 = gelu2x8(HI2(v1));
                    w[2 * bj] = pk4_fp8_nc(r0.x, r0.y, r1.x, r1.y); w[2 * bj + 1] = pk4_fp8_nc(r2.x, r2.y, r3.x, r3.y); }
                *(u32x4*)(O + (size_t)(row0 + ai * 128 + m * 16) * 4096 + col0) = w; }
    }
};

struct GemmG3 : GemmBase {
    static constexpr bool FP8 = true; static constexpr int PERMK = 2;
    const unsigned char* A; const unsigned char* Bt; bf16_t* Z; const bf16_t* R;
    __device__ __forceinline__ bool next(int i, pg8::Unit& u) const { int pm, pn; if (!pg8::static_unit((long)i * G + c, NTOK / 256, 8, pm, pn)) return false;
        u.a = (const char*)A + (size_t)pm * 256 * D; u.b = (const char*)Bt + (size_t)pn * 256 * D; u.x = pm; u.y = pn; return true; }
    __device__ __forceinline__ void epi(const pg8::Acc& acc, const pg8::Unit& u, int wr, int wc, int fr, int fq) const {
        const int row0 = u.x * 256 + wr * 64 + fr, col0 = u.y * 256 + wc * 64 + 16 * fq;
        constexpr float SM = SC_Z / (SC_P * SC_AWO);
        unsigned char* Z8 = (unsigned char*)Z;
#pragma unroll
        for (int ai = 0; ai < 2; ++ai)
#pragma unroll
            for (int m = 0; m < 4; ++m) { u32x4 w;
#pragma unroll
                for (int bj = 0; bj < 2; ++bj) { const f32x4 v0 = acc[ai][bj][m][0] * SM, v1 = acc[ai][bj][m][1] * SM; w[2 * bj] = pk4_fp8_nc(v0[0], v0[1], v0[2], v0[3]); w[2 * bj + 1] = pk4_fp8_nc(v1[0], v1[1], v1[2], v1[3]); }
                *(u32x4*)(Z8 + (size_t)(row0 + ai * 128 + m * 16) * D + col0) = w; }
    }
};

struct GemmS1 : GemmBase {
    static constexpr bool FP8 = true; static constexpr int PERMK = 2;
    const unsigned char* A; const unsigned char* Bt; bf16_t* A2;
    __device__ __forceinline__ bool next(int i, pg8::Unit& u) const { int pm, pn; if (!pg8::static_unit((long)i * G + c, NTOK / 256, 4, pm, pn)) return false;
        u.a = (const char*)A + (size_t)pm * 256 * D; u.b = (const char*)Bt + (size_t)pn * 256 * D; u.x = pm; u.y = pn; return true; }
    __device__ __forceinline__ void epi(const pg8::Acc& acc, const pg8::Unit& u, int wr, int wc, int fr, int fq) const {
        const int row0 = u.x * 256 + wr * 64 + fr, col0 = u.y * 256 + wc * 64 + 16 * fq;
        constexpr float SU = 1.0f / SC_BW;
        const int gg = col0 >> 4;
#pragma unroll
        for (int ai = 0; ai < 2; ++ai)
#pragma unroll
            for (int m = 0; m < 4; ++m) { const int tok = row0 + ai * 128 + m * 16; const int rr = tok >> 4, ii = tok & 15; bf16_t* dst = A2 + ((size_t)gg * 2048 + rr) * 384 + ii * 16;
#pragma unroll
                for (int bj = 0; bj < 2; ++bj) { const f32x4 v0 = acc[ai][bj][m][0] * SU, v1 = acc[ai][bj][m][1] * SU;
                    u32x4 w; w.x = cvt_pk_bf16(v0[0], v0[1]); w.y = cvt_pk_bf16(v0[2], v0[3]); w.z = cvt_pk_bf16(v1[0], v1[1]); w.w = cvt_pk_bf16(v1[2], v1[3]);
                    *(u32x4*)(dst + bj * 8) = w; } }
    }
};

struct GemmS2 : GemmBase {
    static constexpr int PERMK = 0;
    const bf16_t* A2; const bf16_t* Et; float* Xend;
    __device__ __forceinline__ bool next(int i, pg8::Unit& u) const { const long v = (long)i * G + c; if (v >= 512) return false; const int gg = (int)(v >> 3), pm = (int)(v & 7);
        u.a = (const char*)A2 + ((size_t)gg * 2048 + pm * 256) * 384 * 2; u.b = (const char*)Et + (size_t)gg * 256 * 256 * 2; u.x = gg; u.y = pm; return true; }
    __device__ __forceinline__ void epi(const pg8::Acc& acc, const pg8::Unit& u, int wr, int wc, int fr, int fq) const {
        const int row0 = u.y * 256 + wr * 64 + fr, col0 = wc * 32 + 4 * fq;
#pragma unroll
        for (int ai = 0; ai < 2; ++ai)
#pragma unroll
            for (int m = 0; m < 4; ++m) { float* rowp = Xend + ((size_t)u.x * 2048 + row0 + ai * 128 + m * 16) * 128 + col0;
#pragma unroll
                for (int n = 0; n < 2; ++n) *(f32x4*)(rowp + n * 16) = acc[ai][0][m][n]; }
    }
};

struct GemmS4 : GemmBase {
    static constexpr int PERMK = 2;
    const bf16_t* A2; const bf16_t* Bs; unsigned char* Y;
    __device__ __forceinline__ bool next(int i, pg8::Unit& u) const { const long v = (long)i * G + c; if (v >= 512) return false; const int gg = (int)(v >> 3), pm = (int)(v & 7);
        u.a = (const char*)A2 + ((size_t)gg * 2048 + pm * 256) * 384 * 2; u.b = (const char*)Bs + (size_t)gg * 256 * 384 * 2; u.x = gg; u.y = pm; return true; }
    __device__ __forceinline__ void epi(const pg8::Acc& acc, const pg8::Unit& u, int wr, int wc, int fr, int fq) const {
        const int row0 = u.y * 256 + wr * 64 + fr, col0 = wc * 64 + 16 * fq;
#pragma unroll
        for (int ai = 0; ai < 2; ++ai)
#pragma unroll
            for (int m = 0; m < 4; ++m) { u32x4 w;
#pragma unroll
                for (int bj = 0; bj < 2; ++bj) { const f32x4 v0 = acc[ai][bj][m][0], v1 = acc[ai][bj][m][1];
                    static_assert(SC_YS == 8.0f, "gelu2x8"); const f32x2 r0 = gelu2x8(LO2(v0)), r1 = gelu2x8(HI2(v0)), r2 = gelu2x8(LO2(v1)), r3 = gelu2x8(HI2(v1));
                    w[2 * bj] = pk4_fp8_nc(r0.x, r0.y, r1.x, r1.y); w[2 * bj + 1] = pk4_fp8_nc(r2.x, r2.y, r3.x, r3.y); }
                *(u32x4*)(Y + ((size_t)u.x * 2048 + row0 + ai * 128 + m * 16) * 256 + col0) = w; }
    }
};

struct GemmS5 : GemmBase {
    static constexpr bool FP8 = true;
    const unsigned char* Y; const unsigned char* Bt; bf16_t* Z; const bf16_t* R;
    __device__ __forceinline__ unsigned voffA(int Rr, int C, int h) const { return (unsigned)((C >> 3) * 2048 * 256 + (Rr >> 4) * 256 + (Rr & 15) * 16 + h * 2048); }
    __device__ __forceinline__ bool next(int i, pg8::Unit& u) const { int pm, pn; if (!pg8::static_unit((long)i * G + c, NTOK / 256, 16, pm, pn)) return false;
        u.a = (const char*)Y + (size_t)pm * 16 * 256; u.b = (const char*)Bt + (size_t)pn * 256 * BW; u.x = pm; u.y = pn; return true; }
    __device__ __forceinline__ void epi(const pg8::Acc& acc, const pg8::Unit& u, int wr, int wc, int fr, int fq) const {
        const int row0 = u.x * 256 + wr * 64 + fr, col0 = u.y * 128 + wc * 32 + 8 * fq;
        constexpr float SV = 1.0f / (SC_YS * SC_BW);
#pragma unroll
        for (int ai = 0; ai < 2; ++ai)
#pragma unroll
            for (int m = 0; m < 4; ++m) { const size_t off = (size_t)(row0 + ai * 128 + m * 16) * D + col0;
                const f32x4 a0 = acc[ai][0][m][0] * SV, a1 = acc[ai][0][m][1] * SV, g0 = acc[ai][1][m][0] * SV, g1 = acc[ai][1][m][1] * SV;
                const f32x2 r0 = LO2(a0) * sig2(LO2(g0)) * SC_Z, r1 = HI2(a0) * sig2(HI2(g0)) * SC_Z, r2 = LO2(a1) * sig2(LO2(g1)) * SC_Z, r3 = HI2(a1) * sig2(HI2(g1)) * SC_Z;
                u32x2 w; w.x = pk4_fp8_nc(r0.x, r0.y, r1.x, r1.y); w.y = pk4_fp8_nc(r2.x, r2.y, r3.x, r3.y);
                *(u32x2*)((unsigned char*)Z + off) = w; }
    }
};

struct MoeTab { const LAS int* tp; const LAS int* sb; const LAS int* cnt; int nU; };
__device__ __forceinline__ bool moe_unit(const MoeTab& T, long L, int& e, int& mt, int& pn) {
    const int nU = T.nU; if (L >= nU) return false;
    int v; { const int q = nU / 8, r = nU % 8, xcd = (int)(L % 8), off = (int)(L / 8); v = (xcd < r ? xcd * (q + 1) : r * (q + 1) + (xcd - r) * q) + off; }
    const int tile = v >> 3;
    int ee = 0;
#pragma unroll
    for (int j = 1; j < 16; ++j) ee += (tile >= __builtin_amdgcn_readfirstlane(T.tp[j])) ? 1 : 0;
    const int tp0 = __builtin_amdgcn_readfirstlane(T.tp[ee]), tp1 = __builtin_amdgcn_readfirstlane(T.tp[ee + 1]);
    const int tiles_e = tp1 - tp0, ve = v - 8 * tp0;
    const int gid = ve >> 6, fm = gid * 8, gsz = (tiles_e - fm) < 8 ? (tiles_e - fm) : 8, rem = ve - 64 * gid;
    e = ee; mt = fm + rem % gsz; pn = rem / gsz; return true;
}

struct GemmM1 : GemmBase {
    static constexpr bool GATHER = true, FP8 = true;
    const unsigned char* H8; const unsigned char* Bt; unsigned char* ACT; MoeTab T; const LAS int* rows;
    __device__ __forceinline__ unsigned gatherA(int ui, int Rr, int C, int h) const { return (unsigned)rows[ui * 256 + h * 128 + Rr] * (unsigned)D + (unsigned)C * 2u; }
    __device__ __forceinline__ bool next(int i, pg8::Unit& u) const { int e, mt, pn; if (!moe_unit(T, (long)i * G + c, e, mt, pn)) return false;
        u.a = (const char*)H8; u.b = (const char*)Bt + ((size_t)e * 2048 + pn * 256) * D; u.x = __builtin_amdgcn_readfirstlane(T.sb[e]) + mt * 256; u.y = pn; u.z = e; u.w = mt; return true; }
    __device__ __forceinline__ void epi(const pg8::Acc& acc, const pg8::Unit& u, int wr, int wc, int fr, int fq) const {
        const int row0 = u.x + wr * 64 + fr, col0 = u.y * 128 + wc * 32 + 8 * fq;
        constexpr float SG = 1.0f / SC_WIN, SU = SC_ACT / SC_WIN;
#pragma unroll
        for (int ai = 0; ai < 2; ++ai)
#pragma unroll
            for (int m = 0; m < 4; ++m) { const f32x4 a0 = acc[ai][0][m][0] * SG, a1 = acc[ai][0][m][1] * SG, u0 = acc[ai][1][m][0] * SU, u1 = acc[ai][1][m][1] * SU;
                const f32x2 r0 = LO2(a0) * sig2(LO2(a0)) * LO2(u0), r1 = HI2(a0) * sig2(HI2(a0)) * HI2(u0), r2 = LO2(a1) * sig2(LO2(a1)) * LO2(u1), r3 = HI2(a1) * sig2(HI2(a1)) * HI2(u1);
                u32x2 w; w.x = pk4_fp8(r0.x, r0.y, r1.x, r1.y); w.y = pk4_fp8(r2.x, r2.y, r3.x, r3.y);
                *(u32x2*)(ACT + (size_t)(row0 + ai * 128 + m * 16) * DFF + col0) = w; }
    }
};
struct GemmM2 : GemmBase {
    static constexpr bool FP8 = true; static constexpr int PERMK = 2;
    const unsigned char* ACT; const unsigned char* Bt; unsigned char* YB; MoeTab T;
    __device__ __forceinline__ bool next(int i, pg8::Unit& u) const { int e, mt, pn; if (!moe_unit(T, (long)i * G + c, e, mt, pn)) return false;
        const int r0 = __builtin_amdgcn_readfirstlane(T.sb[e]) + mt * 256; u.a = (const char*)ACT + (size_t)r0 * DFF; u.b = (const char*)Bt + ((size_t)e * 2048 + pn * 256) * DFF; u.x = r0; u.y = pn; return true; }
    __device__ __forceinline__ void epi(const pg8::Acc& acc, const pg8::Unit& u, int wr, int wc, int fr, int fq) const {
        const int row0 = u.x + wr * 64 + fr, col0 = u.y * 256 + wc * 64 + 16 * fq;
        constexpr float SY = SC_Y / (SC_ACT * SC_WOUT);
#pragma unroll
        for (int ai = 0; ai < 2; ++ai)
#pragma unroll
            for (int m = 0; m < 4; ++m) { u32x4 w;
#pragma unroll
                for (int bj = 0; bj < 2; ++bj) { const f32x4 v0 = acc[ai][bj][m][0] * SY, v1 = acc[ai][bj][m][1] * SY;
                    w[2 * bj] = pk4_fp8_nc(v0[0], v0[1], v0[2], v0[3]); w[2 * bj + 1] = pk4_fp8_nc(v1[0], v1[1], v1[2], v1[3]); }
                *(u32x4*)(YB + (size_t)(row0 + ai * 128 + m * 16) * D + col0) = w; }
    }
};

struct Args { const float* in[26]; float* out; unsigned char* ws; int ph_lo, ph_hi, flags, pad; };
struct Frame {
    LAS unsigned char* lds; unsigned char* ws; unsigned* ctl;
    int tid, lane, wave, G, bx;
};

__device__ __forceinline__ void transpose_item(const float* __restrict__ src, int ldsrc, int k0, int srccol0, bf16_t* __restrict__ dst, int ldt, int dstrow0, LAS unsigned char* scr, int tid) {
    const int a = tid >> 5, nq = tid & 31;
    f32x4 v[8];
#pragma unroll
    for (int r = 0; r < 8; ++r) v[r] = *(const f32x4*)(src + (size_t)(k0 + 8 * a + r) * ldsrc + srccol0 + 4 * nq);
#pragma unroll
    for (int j = 0; j < 4; ++j) { u32x4 w; w.x = cvt_pk_bf16(v[0][j], v[1][j]); w.y = cvt_pk_bf16(v[2][j], v[3][j]); w.z = cvt_pk_bf16(v[4][j], v[5][j]); w.w = cvt_pk_bf16(v[6][j], v[7][j]);
        const int n = 4 * nq + j; *(LAS u32x4*)(scr + n * 256 + ((a ^ ((n >> 2) & 15)) << 4)) = w; }
    __syncthreads();
#pragma unroll
    for (int q = 0; q < 4; ++q) { const int idx = tid + 512 * q, n = idx >> 4, ch = idx & 15;
        const u32x4 w = *(const LAS u32x4*)(scr + n * 256 + ((ch ^ ((n >> 2) & 15)) << 4));
        *(u32x4*)(dst + (size_t)(dstrow0 + n) * ldt + k0 + 8 * ch) = w; }
    __syncthreads();
}
__device__ __forceinline__ void transpose_item_f8(const float* __restrict__ src, int ldsrc, int k0, int srccol0, unsigned char* __restrict__ dst, int ldt, int dstrow0, float sc, LAS unsigned char* scr, int tid) {
    const int a = tid >> 5, nq = tid & 31;
#pragma unroll
    for (int h = 0; h < 2; ++h) {
        f32x4 v[8];
#pragma unroll
        for (int r = 0; r < 8; ++r) v[r] = *(const f32x4*)(src + (size_t)(k0 + 128 * h + 8 * a + r) * ldsrc + srccol0 + 4 * nq) * sc;
#pragma unroll
        for (int j = 0; j < 4; ++j) { u32x2 w; w.x = pk4_fp8(v[0][j], v[1][j], v[2][j], v[3][j]); w.y = pk4_fp8(v[4][j], v[5][j], v[6][j], v[7][j]);
            const int n = 4 * nq + j, c16 = 8 * h + (a >> 1); *(LAS u32x2*)(scr + n * 256 + ((c16 ^ ((n >> 2) & 15)) << 4) + (a & 1) * 8) = w; }
    }
    __syncthreads();
#pragma unroll
    for (int q = 0; q < 4; ++q) { const int idx = tid + 512 * q, n = idx >> 4, ch = idx & 15;
        const u32x4 w = *(const LAS u32x4*)(scr + n * 256 + ((ch ^ ((n >> 2) & 15)) << 4));
        *(u32x4*)(dst + (size_t)(dstrow0 + n) * ldt + k0 + 16 * ch) = w; }
    __syncthreads();
}
__device__ __forceinline__ void transpose_job_f8(Frame& F, const float* src, unsigned char* dst, int nmat, int K, int N, bool glu, float sc, int& itbase) {
    const int kb = K / 256, nb = N / 128, per = kb * nb, total = nmat * per;
    int first = (F.bx - itbase % F.G + F.G) % F.G;
    for (int it = first; it < total; it += F.G) {
        const int m = it / per, r = it % per, kk = r / nb, nn = r % nb;
        const int srccol0 = glu ? ((nn & 1) * (N / 2) + (nn >> 1) * 128) : nn * 128;
        transpose_item_f8(src + (size_t)m * K * N, N, kk * 256, srccol0, dst + (size_t)m * K * N, K, nn * 128, sc, F.lds, F.tid);
    }
    itbase += total;
}
__device__ __forceinline__ void transpose_job(Frame& F, const float* src, bf16_t* dst, int nmat, int K, int N, bool glu, int& itbase) {
    const int kb = K / 128, nb = N / 128, per = kb * nb, total = nmat * per;
    int first = (F.bx - itbase % F.G + F.G) % F.G;
    for (int it = first; it < total; it += F.G) {
        const int m = it / per, r = it % per, kk = r / nb, nn = r % nb;
        const int srccol0 = glu ? ((nn & 1) * (N / 2) + (nn >> 1) * 128) : nn * 128;
        transpose_item(src + (size_t)m * K * N, N, kk * 128, srccol0, dst + (size_t)m * K * N, K, nn * 128, F.lds, F.tid);
    }
    itbase += total;
}

__device__ __forceinline__ void ssm_precompute(Frame& F, const float* const* in, int g) {
    const float* a_re = in[9]; const float* a_im = in[10]; const float* log_dt = in[11]; const float* b_re = in[12]; const float* b_im = in[13];
    const float* c_re = in[14]; const float* c_im = in[15]; const float* dsk = in[16];
    LAS float* PW = (LAS float*)F.lds;
    LAS float* BB = PW + 64 * 17 * 2;
    LAS float* CC = BB + 64 * 16 * 2;
    LAS float* KM = CC + 16 * 64 * 2;
    bf16_t* Bs = (bf16_t*)(F.ws + WS_SSMB) + (size_t)g * 256 * 384;
    bf16_t* Et = (bf16_t*)(F.ws + WS_SSME) + (size_t)g * 256 * 256;
    const float dt = expf(log_dt[g]);
    __syncthreads();
    for (int idx = F.tid; idx < 64 * 17; idx += NTHR) { const int p = idx / 17, k = idx % 17; const float zr = a_re[g * 64 + p] * dt * (float)k, zi = a_im[g * 64 + p] * dt * (float)k;
        const float mag = expf(zr); float sn, cs; sincosf(zi, &sn, &cs); PW[idx * 2] = mag * cs; PW[idx * 2 + 1] = mag * sn; }
    for (int idx = F.tid; idx < 64 * 16; idx += NTHR) { const int p = idx >> 4, c = idx & 15; const float ar = a_re[g * 64 + p], ai = a_im[g * 64 + p];
        const float zr = ar * dt, zi = ai * dt; const float mag = expf(zr); float sn, cs; sincosf(zi, &sn, &cs);
        const float nr = mag * cs - 1.0f, ni = mag * sn;
        const float den = 1.0f / (ar * ar + ai * ai); const float qr = (nr * ar + ni * ai) * den, qi = (ni * ar - nr * ai) * den;
        const float br = b_re[(g * 64 + p) * 16 + c], bi = b_im[(g * 64 + p) * 16 + c];
        BB[idx * 2] = qr * br - qi * bi; BB[idx * 2 + 1] = qr * bi + qi * br; }
    for (int idx = F.tid; idx < 16 * 64; idx += NTHR) { const int c = idx >> 6, p = idx & 63; CC[idx * 2] = c_re[(g * 16 + c) * 64 + p]; CC[idx * 2 + 1] = c_im[(g * 16 + c) * 64 + p]; }
    __syncthreads();
    for (int idx = F.tid; idx < 4096; idx += NTHR) { const int k = idx >> 8, c = (idx >> 4) & 15, cp = idx & 15; float s = 0.f;
        for (int p = 0; p < 64; ++p) { const float cr = CC[(c * 64 + p) * 2], ci = CC[(c * 64 + p) * 2 + 1], pr = PW[(p * 17 + k) * 2], pi = PW[(p * 17 + k) * 2 + 1], br = BB[(p * 16 + cp) * 2], bi = BB[(p * 16 + cp) * 2 + 1];
            const float tr = cr * pr - ci * pi, ti = cr * pi + ci * pr; s += tr * br - ti * bi; }
        KM[idx] = s; }
    __syncthreads();
    for (int idx = F.tid; idx < 256 * 256; idx += NTHR) { const int n = idx >> 8, kq = idx & 255, i = n >> 4, c = n & 15, ip = kq >> 4, cp = kq & 15;
        float v = 0.f; if (ip <= i) v = KM[((i - ip) * 16 + c) * 16 + cp]; if (ip == i && c == cp) v += dsk[g * 16 + c];
        Bs[(size_t)n * 384 + kq] = (bf16_t)f2bf(v); }
    for (int idx = F.tid; idx < 256 * 64; idx += NTHR) { const int n = idx >> 6, p = idx & 63, i = n >> 4, c = n & 15;
        const float cr = CC[(c * 64 + p) * 2], ci = CC[(c * 64 + p) * 2 + 1], pr = PW[(p * 17 + i + 1) * 2], pi = PW[(p * 17 + i + 1) * 2 + 1];
        Bs[(size_t)n * 384 + 256 + p] = (bf16_t)f2bf(cr * pr - ci * pi); Bs[(size_t)n * 384 + 320 + p] = (bf16_t)f2bf(-(cr * pi + ci * pr)); }
    for (int idx = F.tid; idx < 256 * 256; idx += NTHR) { const int n = idx >> 8, kq = idx & 255, ip = kq >> 4, cp = kq & 15; float v = 0.f;
        if (n < 128) { const int p = n & 63; const float pr = PW[(p * 17 + 15 - ip) * 2], pi = PW[(p * 17 + 15 - ip) * 2 + 1], br = BB[(p * 16 + cp) * 2], bi = BB[(p * 16 + cp) * 2 + 1];
            v = (n < 64) ? (pr * br - pi * bi) : (pr * bi + pi * br); }
        Et[(size_t)n * 256 + kq] = (bf16_t)f2bf(v); }
    __syncthreads();
}

__device__ __forceinline__ void p0_prologue(Frame& F, const float* const* in) {
    unsigned char* ws = F.ws;
    if (F.bx < 64) ssm_precompute(F, in, F.bx);
    { const float* w_s = in[5]; bf16_t* wt = (bf16_t*)(ws + WS_WTRIL);
      for (int idx = F.bx * NTHR + F.tid; idx < 8 * 128 * 128; idx += F.G * NTHR) { const int t = (idx >> 7) & 127, s = idx & 127; wt[idx] = (s <= t) ? (bf16_t)f2bf(w_s[idx]) : (bf16_t)0; } }
    { const float* rw = in[20]; u32x4* rwf = (u32x4*)(ws + WS_RWF);
      for (int idx = F.bx * NTHR + F.tid; idx < 8 * 8 * 64; idx += F.G * NTHR) { const int ln = idx & 63, kk = (idx >> 6) & 7, wv = idx >> 9, e = ln & 15, q = ln >> 4;
          unsigned hi[8], lo[8];
#pragma unroll
          for (int j = 0; j < 8; ++j) { const float w = rw[(size_t)(256 * wv + 32 * kk + 8 * q + j) * 16 + e]; hi[j] = f2bf(w); lo[j] = f2bf(w - __uint_as_float(hi[j] << 16)); }
          rwf[((wv * 8 + kk) * 2) * 64 + ln] = (u32x4){hi[0] | (hi[1] << 16), hi[2] | (hi[3] << 16), hi[4] | (hi[5] << 16), hi[6] | (hi[7] << 16)};
          rwf[((wv * 8 + kk) * 2 + 1) * 64 + ln] = (u32x4){lo[0] | (lo[1] << 16), lo[2] | (lo[3] << 16), lo[4] | (lo[5] << 16), lo[6] | (lo[7] << 16)}; } }
    int itbase = 0;
    transpose_job_f8(F, in[1], ws + WS_WIN, 1, 2048, 4096, false, SC_AWI, itbase);
    transpose_job_f8(F, in[7], ws + WS_WOUT, 1, 2048, 2048, false, SC_AWO, itbase);
    transpose_job_f8(F, in[8], ws + WS_BWIN, 1, 2048, 1024, false, SC_BW, itbase);
    transpose_job_f8(F, in[17], ws + WS_BWOUT, 1, 1024, 4096, true, SC_BW, itbase);
    { const float* x = in[0]; bf16_t* xb = (bf16_t*)(ws + WS_A); unsigned char* x8 = ws + WS_X8;
      constexpr int NBLK = (int)((size_t)NTOK * D / 8 / 2048);
      LAS int* qv = (LAS int*)(F.lds + LDS_MOE + 448);
      for (;;) { __syncthreads(); if (F.tid == 0) *qv = (int)__hip_atomic_fetch_add(F.ctl + CW_XQ, 1u, __ATOMIC_RELAXED, __HIP_MEMORY_SCOPE_AGENT);
          __syncthreads(); const int blk = __builtin_amdgcn_readfirstlane(*qv); if (blk >= NBLK) break;
          f32x4 a[4], b[4];
#pragma unroll
          for (int q = 0; q < 4; ++q) { const size_t i = (size_t)blk * 2048 + q * 512 + F.tid; a[q] = *(const f32x4*)(x + i * 8); b[q] = *(const f32x4*)(x + i * 8 + 4); }
#pragma unroll
          for (int q = 0; q < 4; ++q) { const size_t i = (size_t)blk * 2048 + q * 512 + F.tid;
              u32x4 w; w.x = cvt_pk_bf16(a[q][0], a[q][1]); w.y = cvt_pk_bf16(a[q][2], a[q][3]); w.z = cvt_pk_bf16(b[q][0], b[q][1]); w.w = cvt_pk_bf16(b[q][2], b[q][3]); *(u32x4*)(xb + i * 8) = w;
              u32x2 w8; w8.x = pk4_fp8(a[q][0], a[q][1], a[q][2], a[q][3]); w8.y = pk4_fp8(b[q][0], b[q][1], b[q][2], b[q][3]); *(u32x2*)(x8 + i * 8) = w8; } } }
}

__device__ __forceinline__ int fV(int d) { return (d & 3) | (((d >> 4) & 3) << 2); }
__device__ __forceinline__ void g2_phase(Frame& F, const float* const* in) {
    const unsigned char* UV = F.ws + WS_B; const bf16_t* WT = (const bf16_t*)(F.ws + WS_WTRIL); unsigned char* P8 = F.ws + WS_H8;
    const float* lng = in[3]; const float* lnb = in[4]; const float* b_s = in[6];
    LAS unsigned char* VT = F.lds;
    LAS unsigned char* WSM = F.lds + 65536;
    LAS float* ST = (LAS float*)(F.lds + 98304);
    const int tid = F.tid, lane = F.lane, wave = F.wave, fr = lane & 15, fq = lane >> 4;
    const int sblk = tid >> 5, dblk = tid & 31;
    for (int ch = F.bx; ch < NTOK / CHUNK; ch += F.G) {
        const int tok0 = ch * CHUNK;
        const unsigned char* cUV = UV + (size_t)tok0 * 4096; unsigned char* cP8 = P8 + (size_t)tok0 * D;
        __syncthreads();
        u32x4 wreg[4]; u32x2 vreg[8]; f32x4 gbr[4];
#define G2_LOAD(gg) do { _Pragma("unroll") for (int q = 0; q < 4; ++q) { const int idx = tid + 512 * q; wreg[q] = *(const u32x4*)(WT + ((size_t)(gg) * 128 + (idx >> 4)) * 128 + (idx & 15) * 8); } \
            const int dc_ = (gg) * 256 + dblk * 8; unsigned vo_ = (unsigned)(sblk * 8 * 4096 + 2048 + dc_); asm volatile("" : "+v"(vo_)); \
            _Pragma("unroll") for (int r = 0; r < 8; ++r) vreg[r] = *(const u32x2*)(cUV + (vo_ + r * 4096u)); \
            gbr[0] = *(const f32x4*)(lng + dc_); gbr[1] = *(const f32x4*)(lng + dc_ + 4); gbr[2] = *(const f32x4*)(lnb + dc_); gbr[3] = *(const f32x4*)(lnb + dc_ + 4); } while (0)
        G2_LOAD(0);
#pragma unroll 1
        for (int hb = 0; hb < 2; ++hb) {
            u32x4 w[8][2];
            unsigned so = (unsigned)((wave * 16 + hb * 8) * 4096 + 2048 + lane * 16); asm volatile("" : "+v"(so));
#pragma unroll
            for (int rr = 0; rr < 8; ++rr) { w[rr][0] = *(const u32x4*)(cUV + (so + rr * 4096u)); w[rr][1] = *(const u32x4*)(cUV + (so + rr * 4096u + 1024u)); }
#pragma unroll
            for (int rr = 0; rr < 8; ++rr) { float s = 0.f, s2 = 0.f;
#pragma unroll
                for (int j = 0; j < 2; ++j)
#pragma unroll
                    for (int q = 0; q < 4; ++q) { float f[4]; unpk4_fp8(w[rr][j][q], f);
#pragma unroll
                        for (int e = 0; e < 4; ++e) { s += f[e]; s2 = __builtin_fmaf(f[e], f[e], s2); } }
                s = wave_sum(s) * (1.0f / SC_UV); s2 = wave_sum(s2) * (1.0f / (SC_UV * SC_UV));
                const float mu = s * (1.0f / 2048.0f), var = s2 * (1.0f / 2048.0f) - mu * mu; const int r = wave * 16 + hb * 8 + rr;
                if (lane == 0) { const float rs = __builtin_amdgcn_rsqf(fmaxf(var, 0.f) + LN_EPS); ST[r * 2] = rs * (1.0f / SC_UV); ST[r * 2 + 1] = -mu * rs; } }
        }
        __syncthreads();
#pragma unroll 1
        for (int g = 0; g < AG; ++g) {
#pragma unroll
            for (int q = 0; q < 4; ++q) { const int idx = tid + 512 * q, t = idx >> 4, c16 = idx & 15; *(LAS u32x4*)(WSM + t * 256 + ((c16 ^ (t & 15)) << 4)) = wreg[q]; }
            { unsigned pk[4][8];
#pragma unroll
              for (int rp = 0; rp < 4; ++rp) { const int s0 = sblk * 8 + 2 * rp; const f32x4 st = *(const LAS f32x4*)(ST + s0 * 2);
                  float f0[8], f1[8]; unpk4_fp8(vreg[2 * rp].x, f0); unpk4_fp8(vreg[2 * rp].y, f0 + 4); unpk4_fp8(vreg[2 * rp + 1].x, f1); unpk4_fp8(vreg[2 * rp + 1].y, f1 + 4);
#pragma unroll
                  for (int q = 0; q < 8; ++q) { const float gq = gbr[q >> 2][q & 3], bq = gbr[2 + (q >> 2)][q & 3];
                      pk[rp][q] = cvt_pk_bf16((f0[q] * st[0] + st[1]) * gq + bq, (f1[q] * st[2] + st[3]) * gq + bq); } }
#pragma unroll
              for (int j = 0; j < 8; ++j) { const int d = dblk * 8 + j; u32x4 w; w.x = pk[0][j]; w.y = pk[1][j]; w.z = pk[2][j]; w.w = pk[3][j];
                  *(LAS u32x4*)(VT + d * 256 + ((sblk ^ fV(d)) << 4)) = w; } }
            __syncthreads();
            if (g + 1 < AG) G2_LOAD(g + 1);
            const int wd = wave & 3, wt = wave >> 2;
            u32x4 ureg[4]; float bsr[4];
            unsigned uo = (unsigned)(fr * 4096 + g * 256 + wd * 64 + 16 * fq); asm volatile("" : "+v"(uo));
#pragma unroll
            for (int mi = 0; mi < 4; ++mi) { const int m = 2 * mi + (((mi & 1) ^ wt) ? 1 : 0); ureg[mi] = *(const u32x4*)(cUV + (uo + (unsigned)m * 65536u)); bsr[mi] = b_s[g * 128 + 16 * m + fr]; }
            f32x4 acc[4][4];
#pragma unroll
            for (int mi = 0; mi < 4; ++mi)
#pragma unroll
                for (int n = 0; n < 4; ++n) acc[mi][n] = (f32x4){0.f, 0.f, 0.f, 0.f};
#pragma unroll
            for (int ks = 0; ks < 4; ++ks) {
                bf16x8 bfr[4];
#pragma unroll
                for (int n = 0; n < 4; ++n) { const int d = wd * 64 + 16 * (fr >> 2) + 4 * n + (fr & 3); bfr[n] = *(const LAS bf16x8*)(VT + d * 256 + (((4 * ks + fq) ^ fV(d)) << 4)); }
#pragma unroll
                for (int mi = 0; mi < 4; ++mi) { const int m = 2 * mi + (((mi & 1) ^ wt) ? 1 : 0);
                    if (m >= 2 * ks) { const int t = 16 * m + fr; const bf16x8 afr = *(const LAS bf16x8*)(WSM + t * 256 + (((4 * ks + fq) ^ (t & 15)) << 4));
#pragma unroll
                        for (int n = 0; n < 4; ++n) acc[mi][n] = __builtin_amdgcn_mfma_f32_16x16x32_bf16(bfr[n], afr, acc[mi][n], 0, 0, 0); } }
            }
            unsigned po = (unsigned)(fr * D + g * 256 + wd * 64 + 16 * fq); asm volatile("" : "+v"(po));
#pragma unroll
            for (int mi = 0; mi < 4; ++mi) { const int m = 2 * mi + (((mi & 1) ^ wt) ? 1 : 0); constexpr float SPU = SC_P / SC_UV; const float bs = bsr[mi] * SPU; u32x4 w;
#pragma unroll
                for (int n = 0; n < 4; ++n) { float f[4]; unpk4_fp8(ureg[mi][n], f);
                    w[n] = pk4_fp8(f[0] * (acc[mi][n][0] * SPU + bs), f[1] * (acc[mi][n][1] * SPU + bs), f[2] * (acc[mi][n][2] * SPU + bs), f[3] * (acc[mi][n][3] * SPU + bs)); }
                *(u32x4*)(cP8 + (po + (unsigned)m * 16u * D)) = w; }
            __syncthreads();
        }
#undef G2_LOAD
    }
}

__device__ __forceinline__ void ln_route_phase(Frame& F, const float* const* in, int layer) {
    const bf16_t* Z = (const bf16_t*)(F.ws + WS_C); const bf16_t* RES = (const bf16_t*)(F.ws + WS_A); unsigned char* H8 = F.ws + WS_H8;
    const float* lng = in[18] + layer * D; const float* lnb = in[19] + layer * D; const float* rw = in[20]; const float* rb = in[21];
    int* rowlist = (int*)(F.ws + WS_ROWLIST); i32x4* toki = (i32x4*)(F.ws + WS_TOKI); f32x2* tokg = (f32x2*)(F.ws + WS_TOKG);
    unsigned* gcnt = F.ctl + CW_CNT + 64 * layer;
    LAS unsigned char* T = F.lds;
    LAS float* PART = (LAS float*)(F.lds + 65792);
    LAS int* LCNT = (LAS int*)(F.lds + 65792 + 8192);
    LAS int* LBASE = LCNT + 16;
    LAS int* TE = LBASE + 16;
    LAS int* TR = TE + 512;
    const int tid = F.tid, lane = F.lane, wave = F.wave, fr = lane & 15, fq = lane >> 4;
    u32x2 nz[2][4]; u32x4 nr[2][4];
    const unsigned lo8 = (unsigned)lane * 8u, lo16 = (unsigned)lane * 16u;
#define LR_LD1(rr_, j_, zrow_, rrow_) do { nz[rr_][j_] = *(const u32x2*)((zrow_) + lo8 + (j_) * 512); nr[rr_][j_] = *(const u32x4*)((const unsigned char*)(rrow_) + lo16 + (j_) * 1024); } while (0)
#define LR_ISSUE(grp_) do { const size_t t0_ = (size_t)(grp_) * 16 + 2 * wave; const unsigned char* z0_ = (const unsigned char*)Z + t0_ * D; const bf16_t* r0_ = RES + t0_ * D; \
        const unsigned char* z1_ = z0_ + D; const bf16_t* r1_ = r0_ + D; \
        LR_LD1(0, 0, z0_, r0_); LR_LD1(0, 1, z0_, r0_); LR_LD1(0, 2, z0_, r0_); LR_LD1(0, 3, z0_, r0_); LR_LD1(1, 0, z1_, r1_); LR_LD1(1, 1, z1_, r1_); LR_LD1(1, 2, z1_, r1_); LR_LD1(1, 3, z1_, r1_); } while (0)
    if (F.bx < NTOK / 16) LR_ISSUE(F.bx);
    const f32x4 gld = *(const f32x4*)(lng + 4 * tid), bld = *(const f32x4*)(lnb + 4 * tid);
    bf16x8 rwh[8], rwl[8];
    { const bf16x8* rwf = (const bf16x8*)(F.ws + WS_RWF) + (size_t)wave * 8 * 2 * 64 + lane;
#pragma unroll
      for (int kk = 0; kk < 8; ++kk) { rwh[kk] = rwf[(kk * 2) * 64]; rwl[kk] = rwf[(kk * 2 + 1) * 64]; } }
    LAS float* GB = (LAS float*)(F.lds + 81920);
    __syncthreads();
    *(LAS f32x4*)(GB + 4 * tid) = gld; *(LAS f32x4*)(GB + D + 4 * tid) = bld;
    if (tid < 16) LCNT[tid] = 0;
    __syncthreads();
    int nloc = 0;
    for (int it = 0, grp = F.bx; grp < NTOK / 16; ++it, grp += F.G) {
        u32x2 cz[2][4]; u32x4 cr[2][4];
#pragma unroll
        for (int rr = 0; rr < 2; ++rr)
#pragma unroll
            for (int j = 0; j < 4; ++j) { cz[rr][j] = nz[rr][j]; cr[rr][j] = nr[rr][j]; }
        if (grp + F.G < NTOK / 16) LR_ISSUE(grp + F.G);
#pragma unroll
        for (int rr = 0; rr < 2; ++rr) { const int r = 2 * wave + rr; const size_t tok = (size_t)grp * 16 + r;
            float x[4][8]; float s = 0.f;
#pragma unroll
            for (int j = 0; j < 4; ++j) { const u32x2 w = cz[rr][j]; const u32x4 rv = cr[rr][j];
                float f[8]; unpk4_fp8(w.x, f); unpk4_fp8(w.y, f + 4);
#pragma unroll
                for (int q = 0; q < 4; ++q) { x[j][2 * q] = ALPHA * bf_lo(rv[q]) + f[2 * q] * (1.0f / SC_Z); x[j][2 * q + 1] = ALPHA * bf_hi(rv[q]) + f[2 * q + 1] * (1.0f / SC_Z); s += x[j][2 * q] + x[j][2 * q + 1]; } }
            const float mu = wave_sum(s) * (1.0f / D); float s2 = 0.f;
#pragma unroll
            for (int j = 0; j < 4; ++j)
#pragma unroll
                for (int q = 0; q < 8; ++q) { x[j][q] -= mu; s2 += x[j][q] * x[j][q]; }
            const float rs = __builtin_amdgcn_rsqf(wave_sum(s2) * (1.0f / D) + LN_EPS);
#pragma unroll
            for (int j = 0; j < 4; ++j) { const int c0 = (j * 64 + lane) * 8;
                const f32x4 g0 = *(const LAS f32x4*)(GB + c0), g1 = *(const LAS f32x4*)(GB + c0 + 4), b0 = *(const LAS f32x4*)(GB + D + c0), b1 = *(const LAS f32x4*)(GB + D + c0 + 4);
                float o[8];
#pragma unroll
                for (int q = 0; q < 4; ++q) { o[q] = x[j][q] * rs * g0[q] + b0[q]; o[4 + q] = x[j][4 + q] * rs * g1[q] + b1[q]; }
                u32x4 w; w.x = cvt_pk_bf16(o[0], o[1]); w.y = cvt_pk_bf16(o[2], o[3]); w.z = cvt_pk_bf16(o[4], o[5]); w.w = cvt_pk_bf16(o[6], o[7]);
                *(LAS u32x4*)(T + r * 4112 + (j * 64 + lane) * 16) = w;
                u32x2 w8; w8.x = pk4_fp8(o[0], o[1], o[2], o[3]); w8.y = pk4_fp8(o[4], o[5], o[6], o[7]); *(u32x2*)(H8 + tok * D + c0) = w8; } }
        __syncthreads();
        { f32x4 acc = (f32x4){0.f, 0.f, 0.f, 0.f};
#pragma unroll
          for (int kk = 0; kk < 8; ++kk) { const bf16x8 a = *(const LAS bf16x8*)(T + fr * 4112 + (256 * wave + 32 * kk + 8 * fq) * 2);
              acc = __builtin_amdgcn_mfma_f32_16x16x32_bf16(a, rwh[kk], acc, 0, 0, 0); acc = __builtin_amdgcn_mfma_f32_16x16x32_bf16(a, rwl[kk], acc, 0, 0, 0); }
#pragma unroll
          for (int j = 0; j < 4; ++j) PART[(wave * 16 + 4 * fq + j) * 16 + fr] = acc[j]; }
        __syncthreads();
        if (tid < 16) {
            const int r = tid; const int tok = grp * 16 + r; float lg[16]; float mx = -3.0e38f;
#pragma unroll
            for (int e4 = 0; e4 < 4; ++e4) { const f32x4 b4 = *(const f32x4*)(rb + 4 * e4); lg[4 * e4] = b4[0]; lg[4 * e4 + 1] = b4[1]; lg[4 * e4 + 2] = b4[2]; lg[4 * e4 + 3] = b4[3]; }
#pragma unroll 1
            for (int w = 0; w < 8; ++w) {
#pragma unroll
                for (int e4 = 0; e4 < 4; ++e4) { const f32x4 p4 = *(const LAS f32x4*)(PART + (w * 16 + r) * 16 + 4 * e4); lg[4 * e4] += p4[0]; lg[4 * e4 + 1] += p4[1]; lg[4 * e4 + 2] += p4[2]; lg[4 * e4 + 3] += p4[3]; } }
#pragma unroll
            for (int e = 0; e < 16; ++e) mx = fmaxf(mx, lg[e]);
#pragma unroll
            for (int e = 0; e < 16; ++e) lg[e] = __expf(lg[e] - mx);
            int bg = 0; float bscore = -1.f;
#pragma unroll
            for (int gq = 0; gq < 4; ++gq) { float a = -1.f, b = -1.f;
#pragma unroll
                for (int q = 0; q < 4; ++q) { const float p = lg[4 * gq + q]; if (p > a) { b = a; a = p; } else if (p > b) b = p; }
                const float sc = a + b; if (sc > bscore) { bscore = sc; bg = gq; } }
            int i0 = 0, i1 = 0; float p0 = -1.f, p1 = -1.f;
#pragma unroll
            for (int gq = 0; gq < 4; ++gq) if (gq == bg) {
#pragma unroll
                for (int q = 0; q < 4; ++q) { const float p = lg[4 * gq + q]; if (p > p0) { p1 = p0; i1 = i0; p0 = p; i0 = 4 * gq + q; } else if (p > p1) { p1 = p; i1 = 4 * gq + q; } } }
            const float inv = 1.0f / (p0 + p1);
            tokg[tok] = (f32x2){p0 * inv, p1 * inv};
            const int lt = it * 16 + r;
            TE[lt * 2] = i0; TE[lt * 2 + 1] = i1;
            TR[lt * 2] = atomicAdd((int*)&LCNT[i0], 1); TR[lt * 2 + 1] = atomicAdd((int*)&LCNT[i1], 1);
        }
        nloc = it * 16 + 16;
    }
    __syncthreads();
    if (tid < 16) LBASE[tid] = (int)__hip_atomic_fetch_add(gcnt + tid, (unsigned)LCNT[tid], __ATOMIC_RELAXED, __HIP_MEMORY_SCOPE_AGENT);
    __syncthreads();
    for (int lt = tid; lt < nloc; lt += NTHR) { const int it = lt >> 4, r = lt & 15; const int tok = (F.bx + it * F.G) * 16 + r;
        const int e0 = TE[lt * 2], e1 = TE[lt * 2 + 1]; const int s0 = LBASE[e0] + TR[lt * 2], s1 = LBASE[e1] + TR[lt * 2 + 1];
        rowlist[e0 * NTOK + s0] = tok; rowlist[e1 * NTOK + s1] = tok;
        toki[tok] = (i32x4){e0 | (e1 << 8), s0, s1, 0}; }
    __syncthreads();
}

#undef LR_LD1
#undef LR_ISSUE
__device__ __forceinline__ MoeTab moe_tables(Frame& F, int layer) {
    LAS int* M = (LAS int*)(F.lds + LDS_MOE);
    __syncthreads();
    if (F.tid < 16) M[64 + F.tid] = (int)__hip_atomic_load(F.ctl + CW_CNT + 64 * layer + F.tid, __ATOMIC_RELAXED, __HIP_MEMORY_SCOPE_AGENT);
    __syncthreads();
    if (F.tid == 0) { int tp = 0, sb = 0;
        for (int e = 0; e < 16; ++e) { const int c = M[64 + e]; const int tl = (c + 255) >> 8; M[e] = tp; M[32 + e] = sb; tp += tl; sb += tl * 256; }
        M[16] = tp; }
    __syncthreads();
    MoeTab T; T.tp = M; T.sb = M + 32; T.cnt = M + 64; T.nU = __builtin_amdgcn_readfirstlane(M[16]) * 8; return T;
}

template <bool FINAL>
__device__ __forceinline__ void ln2_phase(Frame& F, const float* const* in, int layer, const MoeTab& T, float* out) {
    const unsigned char* Z8 = F.ws + WS_C; const bf16_t* RES = (const bf16_t*)(F.ws + WS_A); const unsigned char* YB = F.ws + WS_B; bf16_t* H2 = (bf16_t*)(F.ws + WS_A);
    const float* lng1 = in[18] + layer * D; const float* lnb1 = in[19] + layer * D; const float* lng = in[24] + layer * D; const float* lnb = in[25] + layer * D;
    const i32x4* toki = (const i32x4*)(F.ws + WS_TOKI); const f32x2* tokg = (const f32x2*)(F.ws + WS_TOKG);
    const int lane = F.lane;
    LAS float* GB1 = (LAS float*)F.lds;
    static_assert(D / 4 == NTHR, "one affine vector per thread");
    const int gw = F.bx * NWAVES + F.wave, NGW = F.G * NWAVES;
    i32x4 tiN = toki[gw < NTOK ? gw : 0]; f32x2 tgN = tokg[gw < NTOK ? gw : 0];
    { const f32x4 a0 = *(const f32x4*)(lng1 + 4 * F.tid), a1 = *(const f32x4*)(lnb1 + 4 * F.tid), a2 = *(const f32x4*)(lng + 4 * F.tid), a3 = *(const f32x4*)(lnb + 4 * F.tid);
      __syncthreads();
      *(LAS f32x4*)(GB1 + 4 * F.tid) = a0; *(LAS f32x4*)(GB1 + D + 4 * F.tid) = a1; *(LAS f32x4*)(GB1 + 2 * D + 4 * F.tid) = a2; *(LAS f32x4*)(GB1 + 3 * D + 4 * F.tid) = a3; }
    __syncthreads();
    for (int tok = gw; tok < NTOK; tok += NGW) {
        const i32x4 ti = tiN; const f32x2 tg = tgN;
        { const int tn = tok + NGW < NTOK ? tok + NGW : tok; tiN = toki[tn]; tgN = tokg[tn]; }
        const int e0 = ti.x & 255, e1 = (ti.x >> 8) & 255;
        unsigned ro = (unsigned)tok * D + lane * 8, yo0 = (unsigned)(T.sb[e0] + ti.y) * D + lane * 8, yo1 = (unsigned)(T.sb[e1] + ti.z) * D + lane * 8;
        asm volatile("" : "+v"(ro), "+v"(yo0), "+v"(yo1));
        float x[4][8]; u32x2 y0r[4], y1r[4]; float s = 0.f;
#pragma unroll
        for (int j = 0; j < 4; ++j) { const int c0 = (j * 64 + lane) * 8; const u32x2 z8 = *(const u32x2*)(Z8 + ro + j * 512); const u32x4 rv = *(const u32x4*)(RES + ro + j * 512);
            y0r[j] = *(const u32x2*)(YB + yo0 + j * 512); y1r[j] = *(const u32x2*)(YB + yo1 + j * 512);
            float f[8]; unpk4_fp8(z8.x, f); unpk4_fp8(z8.y, f + 4);
#pragma unroll
            for (int q = 0; q < 4; ++q) { x[j][2 * q] = ALPHA * bf_lo(rv[q]) + f[2 * q] * (1.0f / SC_Z); x[j][2 * q + 1] = ALPHA * bf_hi(rv[q]) + f[2 * q + 1] * (1.0f / SC_Z); s += x[j][2 * q] + x[j][2 * q + 1]; } }
        const float mu1 = wave_sum(s) * (1.0f / D); float s2 = 0.f;
#pragma unroll
        for (int j = 0; j < 4; ++j)
#pragma unroll
            for (int q = 0; q < 8; ++q) { x[j][q] -= mu1; s2 += x[j][q] * x[j][q]; }
        const float rs1 = __builtin_amdgcn_rsqf(wave_sum(s2) * (1.0f / D) + LN_EPS);
        const float g0 = tg.x * (1.0f / SC_Y), g1 = tg.y * (1.0f / SC_Y);
        s = 0.f;
#pragma unroll
        for (int j = 0; j < 4; ++j) { const int c0 = (j * 64 + lane) * 8;
            __builtin_amdgcn_sched_barrier(0);
            const f32x4 ga = *(const LAS f32x4*)(GB1 + c0), gb = *(const LAS f32x4*)(GB1 + c0 + 4), ba = *(const LAS f32x4*)(GB1 + D + c0), bb = *(const LAS f32x4*)(GB1 + D + c0 + 4);
            float a0[8], a1[8]; unpk4_fp8(y0r[j].x, a0); unpk4_fp8(y0r[j].y, a0 + 4); unpk4_fp8(y1r[j].x, a1); unpk4_fp8(y1r[j].y, a1 + 4);
#pragma unroll
            for (int q = 0; q < 4; ++q) { const float h0 = x[j][q] * rs1 * ga[q] + ba[q], h1 = x[j][4 + q] * rs1 * gb[q] + bb[q];
                x[j][q] = ALPHA * h0 + g0 * a0[q] + g1 * a1[q]; x[j][4 + q] = ALPHA * h1 + g0 * a0[4 + q] + g1 * a1[4 + q]; s += x[j][q] + x[j][4 + q]; } }
        const float mu = wave_sum(s) * (1.0f / D); s2 = 0.f;
#pragma unroll
        for (int j = 0; j < 4; ++j)
#pragma unroll
            for (int q = 0; q < 8; ++q) { x[j][q] -= mu; s2 += x[j][q] * x[j][q]; }
        const float rs = __builtin_amdgcn_rsqf(wave_sum(s2) * (1.0f / D) + LN_EPS);
#pragma unroll
        for (int j = 0; j < 4; ++j) { const int c0 = (j * 64 + lane) * 8; float o[8];
            __builtin_amdgcn_sched_barrier(0);
            const f32x4 ga = *(const LAS f32x4*)(GB1 + 2 * D + c0), gb = *(const LAS f32x4*)(GB1 + 2 * D + c0 + 4), ba = *(const LAS f32x4*)(GB1 + 3 * D + c0), bb = *(const LAS f32x4*)(GB1 + 3 * D + c0 + 4);
#pragma unroll
            for (int q = 0; q < 4; ++q) { o[q] = x[j][q] * rs * ga[q] + ba[q]; o[4 + q] = x[j][4 + q] * rs * gb[q] + bb[q]; }
            if constexpr (FINAL) { *(f32x4*)(out + ro + j * 512) = (f32x4){o[0], o[1], o[2], o[3]}; *(f32x4*)(out + ro + j * 512 + 4) = (f32x4){o[4], o[5], o[6], o[7]}; }
            else { u32x4 w; w.x = cvt_pk_bf16(o[0], o[1]); w.y = cvt_pk_bf16(o[2], o[3]); w.z = cvt_pk_bf16(o[4], o[5]); w.w = cvt_pk_bf16(o[6], o[7]); *(u32x4*)(H2 + ro + j * 512) = w;
                u32x2 w8; w8.x = pk4_fp8(o[0], o[1], o[2], o[3]); w8.y = pk4_fp8(o[4], o[5], o[6], o[7]); *(u32x2*)(F.ws + WS_H8 + ro + j * 512) = w8; } }
    }
}

__device__ __forceinline__ void scan_phase(Frame& F, const float* const* in) {
    const float* a_re = in[9]; const float* a_im = in[10]; const float* log_dt = in[11];
    const float* Xend = (const float*)(F.ws + WS_XEND); bf16_t* A2 = (bf16_t*)(F.ws + WS_A2);
    for (int i0 = 0; (long)i0 * F.G + F.bx < 512; i0 += 2) {
        const long v = (long)(i0 + (F.tid >> 7)) * F.G + F.bx; if (F.tid >= 256 || v >= 512) continue;
        const int p = F.tid & 63, g = (int)(v >> 3), b = 2 * (int)(v & 7) + ((F.tid >> 6) & 1);
        const float dt = expf(log_dt[g]); const float zr = a_re[g * 64 + p] * dt * 16.0f, zi = a_im[g * 64 + p] * dt * 16.0f;
        const float mag = expf(zr); float sn, cs; sincosf(zi, &sn, &cs); const float ar = mag * cs, ai = mag * sn;
        float xr = 0.f, xi = 0.f; const size_t row0 = (size_t)g * 2048 + b * 128;
#pragma unroll 8
        for (int j = 0; j < 128; ++j) { const size_t row = row0 + j; const float er = Xend[row * 128 + p], ei = Xend[row * 128 + 64 + p];
            A2[row * 384 + 256 + p] = (bf16_t)f2bf(xr); A2[row * 384 + 320 + p] = (bf16_t)f2bf(xi);
            const float nr = ar * xr - ai * xi + er, ni = ar * xi + ai * xr + ei; xr = nr; xi = ni; }
    }
}

__device__ __forceinline__ void conv_slice(int bx, int G, int nA, int wdiff, int base, int total, int& it0, int& it1) {
    int ce = (total - wdiff * (G - nA)) / G; if (ce < 0) ce = 0; const int co = ce + wdiff; int rem = total - (nA * ce + (G - nA) * co); if (rem < 0) rem = 0;
    it0 = (bx < nA ? bx * ce : nA * ce + (bx - nA) * co) + (bx < rem ? bx : rem); it1 = it0 + (bx < nA ? ce : co) + (bx < rem ? 1 : 0);
    if (it0 > total) it0 = total; if (it1 > total) it1 = total; it0 += base; it1 += base;
}
__device__ __forceinline__ void convert_experts(Frame& F, const float* const* in, int layer, int it0, int it1) {
    const float* src0 = in[22] + (size_t)layer * 16 * 2048 * 2048; const float* src1 = in[23] + (size_t)layer * 16 * 1024 * 2048;
    unsigned char* dst0 = F.ws + (layer == 0 ? WS_EIN : WS_EIN1); unsigned char* dst1 = F.ws + (layer == 0 ? WS_EOUT : WS_EOUT1);
    const int tid = F.tid, a = tid >> 5, nq = tid & 31; LAS unsigned char* scr = F.lds;
    const unsigned loff = (unsigned)(8 * a * 2048 + 4 * nq) * 4u;
    f32x4 v[16];
#define CE_DECODE(it_, sp_, dp_, K_, sc_) do { if ((it_) < 2048) { const int m_ = (it_) >> 7, r_ = (it_) & 127, kk_ = r_ >> 4, nn_ = r_ & 15; K_ = 2048; sc_ = SC_WIN; \
            sp_ = src0 + ((size_t)m_ * 2048 + kk_ * 256) * 2048 + (nn_ & 1) * 1024 + (nn_ >> 1) * 128; dp_ = dst0 + ((size_t)m_ * 2048 + nn_ * 128) * 2048 + kk_ * 256; } \
        else { const int i_ = (it_) - 2048, m_ = i_ >> 6, r_ = i_ & 63, kk_ = r_ >> 4, nn_ = r_ & 15; K_ = 1024; sc_ = SC_WOUT; \
            sp_ = src1 + ((size_t)m_ * 1024 + kk_ * 256) * 2048 + nn_ * 128; dp_ = dst1 + ((size_t)m_ * 2048 + nn_ * 128) * 1024 + kk_ * 256; } } while (0)
#define CE_ISSUE(sp_) do { _Pragma("unroll") for (int h = 0; h < 2; ++h) _Pragma("unroll") for (int r = 0; r < 8; ++r) { const float* rp_ = (sp_) + (size_t)(128 * h + r) * 2048; \
            v[8 * h + r] = __builtin_nontemporal_load((const f32x4*)((const char*)rp_ + loff)); } } while (0)
    __syncthreads();
    int it = it0; const float* sp; unsigned char* dp; int K; float sc;
    if (it < it1) { CE_DECODE(it, sp, dp, K, sc); CE_ISSUE(sp); }
    while (it < it1) {
#pragma unroll
        for (int h = 0; h < 2; ++h)
#pragma unroll
            for (int j = 0; j < 4; ++j) { u32x2 w; w.x = pk4_fp8(v[8 * h][j] * sc, v[8 * h + 1][j] * sc, v[8 * h + 2][j] * sc, v[8 * h + 3][j] * sc); w.y = pk4_fp8(v[8 * h + 4][j] * sc, v[8 * h + 5][j] * sc, v[8 * h + 6][j] * sc, v[8 * h + 7][j] * sc);
                const int n = 4 * nq + j, c16 = 8 * h + (a >> 1); *(LAS u32x2*)(scr + n * 256 + ((c16 ^ ((n >> 2) & 15)) << 4) + (a & 1) * 8) = w; }
        unsigned char* dcur = dp; const int Kcur = K; const int nx = it + 1;
        if (nx < it1) { CE_DECODE(nx, sp, dp, K, sc); CE_ISSUE(sp); }
        __syncthreads();
#pragma unroll
        for (int q = 0; q < 4; ++q) { const int idx = tid + 512 * q, n = idx >> 4, ch = idx & 15;
            const u32x4 w = *(const LAS u32x4*)(scr + n * 256 + ((ch ^ ((n >> 2) & 15)) << 4));
            *(u32x4*)(dcur + (size_t)n * Kcur + 16 * ch) = w; }
        __syncthreads();
        it = nx;
    }
#undef CE_DECODE
#undef CE_ISSUE
}
#ifndef PHASE_MASK
#define PHASE_MASK 0x1ffff
#endif
template <int LAYER>
__device__ __forceinline__ void moe_block(Frame& F, const Args& args, const XcdBarrier& bar) {
    const int lo = args.ph_lo, hi = args.ph_hi; const float* const* in = args.in; unsigned char* ws = args.ws;
    constexpr int pb = LAYER == 0 ? 4 : 13;
#define IN(k) (((PHASE_MASK >> (k)) & 1) && lo <= (k) && (k) < hi)
#define SEAM(k) do { if (IN(k) && IN((k) + 1)) xcd_barrier(bar); } while (0)
    if (IN(pb)) { ln_route_phase(F, in, LAYER); } SEAM(pb);
    MoeTab T; T.tp = nullptr; T.sb = nullptr; T.cnt = nullptr; T.nU = 0;
    if (IN(pb + 1)) { T = moe_tables(F, LAYER);
        GemmM1 g; g.nostore = args.flags & 1; g.init_bytes(2048, 2048, F.G, F.bx); g.H8 = ws + WS_H8; g.Bt = ws + (LAYER == 0 ? WS_EIN : WS_EIN1); g.ACT = ws + WS_D; g.T = T;
        LAS int* rows = (LAS int*)(F.lds + LDS_ROWS); g.rows = rows;
        const int* rowlist = (const int*)(ws + WS_ROWLIST);
        { const int r_ = F.tid & 255, uh = F.tid >> 8; int idx[5], vals[5];
#pragma unroll
          for (int k = 0; k < 5; ++k) { pg8::Unit u; int ix = -1;
              if (g.next(uh + 2 * k, u)) { const int slot = u.w * 256 + r_; if (slot < __builtin_amdgcn_readfirstlane(T.cnt[u.z])) ix = u.z * NTOK + slot; }
              idx[k] = ix; }
#pragma unroll
          for (int k = 0; k < 5; ++k) vals[k] = rowlist[idx[k] < 0 ? 0 : idx[k]];
#pragma unroll
          for (int k = 0; k < 5; ++k) rows[(uh + 2 * k) * 256 + r_] = idx[k] < 0 ? 0 : vals[k]; }
        __syncthreads();
        int cv0 = 0, cv1 = 0;
        if constexpr (LAYER == 0) { const int R = T.nU / F.G, nA = T.nU - R * F.G, m2part = 2 * (F.G - nA) < 3072 ? 2 * (F.G - nA) : 0;
            conv_slice(F.bx, F.G, nA, 4, 0, 3072 - m2part, cv0, cv1);
            if (F.bx & 1) convert_experts(F, in, 1, cv0, cv1); }
        pg8::gemm_phase(F.lds, g);
        if constexpr (LAYER == 0) { if (!(F.bx & 1)) convert_experts(F, in, 1, cv0, cv1); } } SEAM(pb + 1);
    if (IN(pb + 2)) { if (!IN(pb + 1)) T = moe_tables(F, LAYER);
        GemmM2 g; g.nostore = args.flags & 1; g.init_bytes(1024, 1024, F.G, F.bx); g.ACT = ws + WS_D; g.Bt = ws + (LAYER == 0 ? WS_EOUT : WS_EOUT1); g.YB = ws + WS_B; g.T = T; g.hstepB = (size_t)8 * g.ldb2;
        int cw0 = 0, cw1 = 0;
        if constexpr (LAYER == 0) { const int R = T.nU / F.G, nA = T.nU - R * F.G, m2part = 2 * (F.G - nA) < 3072 ? 2 * (F.G - nA) : 0;
            if (F.bx >= nA && m2part) { cw0 = 3072 - m2part + 2 * (F.bx - nA); cw1 = cw0 + 2; }
            if ((F.bx & 1) && cw1 > cw0) convert_experts(F, in, 1, cw0, cw1); }
        pg8::gemm_phase(F.lds, g);
        if constexpr (LAYER == 0) { if (!(F.bx & 1) && cw1 > cw0) convert_experts(F, in, 1, cw0, cw1); } } SEAM(pb + 2);
    if (IN(pb + 3)) { if (!IN(pb + 1)) T = moe_tables(F, LAYER);
        if constexpr (LAYER == 0) { ln2_phase<false>(F, in, 0, T, nullptr); }
        else ln2_phase<true>(F, in, 1, T, args.out); }
#undef IN
#undef SEAM
}

constexpr int N_PHASES = 17;
__global__ void __launch_bounds__(NTHR, 2) fwd_kernel(Args args) {
    extern __shared__ __attribute__((aligned(16))) unsigned char lds_raw[];
    Frame F; F.lds = (LAS unsigned char*)lds_raw; F.ws = args.ws; F.ctl = (unsigned*)(args.ws + WS_CTL);
    F.tid = threadIdx.x; F.lane = F.tid & 63; F.wave = __builtin_amdgcn_readfirstlane(F.tid >> 6); F.G = gridDim.x; F.bx = blockIdx.x;
    if (F.tid < 4) ((LAS unsigned*)(F.lds + LDS_BARW))[F.tid] = 0u;
    __syncthreads();
    XcdBarrier bar; bar.bar = F.ctl + CW_BAR; bar.x = 0; bar.st = nullptr;
    const bool one = (args.ph_hi - args.ph_lo) > 1;
    if (one) bar = xcd_barrier_post(F.ctl + CW_BAR, (volatile LAS unsigned*)(F.lds + LDS_BARW));
    const int lo = args.ph_lo, hi = args.ph_hi;
#ifndef PHASE_MASK
#define PHASE_MASK 0x1ffff
#endif
#define IN(k) (((PHASE_MASK >> (k)) & 1) && lo <= (k) && (k) < hi)
#define SEAM(k) do { if (IN(k) && IN((k) + 1)) xcd_barrier(bar); } while (0)
    const float* const* in = args.in;
    unsigned char* ws = args.ws;

    if (IN(0)) { p0_prologue(F, in); } SEAM(0);
    if (IN(1)) { GemmG1 g; g.nostore = args.flags & 1; g.init_bytes(2048, 2048, F.G, F.bx); g.A = ws + WS_X8; g.Bt = ws + WS_WIN; g.O = ws + WS_B; g.bias = in[2]; g.hstepB = (size_t)8 * g.ldb2;
        int cv0, cv1; conv_slice(F.bx, F.G, 0, 0, 0, 3072, cv0, cv1);
        if (F.bx & 1) convert_experts(F, in, 0, cv0, cv1);
        pg8::gemm_phase(F.lds, g);
        if (!(F.bx & 1)) convert_experts(F, in, 0, cv0, cv1); } SEAM(1);
    if (IN(2)) { g2_phase(F, in); } SEAM(2);
    if (IN(3)) { GemmG3 g; g.nostore = args.flags & 1; g.init_bytes(2048, 2048, F.G, F.bx); g.A = ws + WS_H8; g.Bt = ws + WS_WOUT; g.Z = (bf16_t*)(ws + WS_C); g.R = (const bf16_t*)(ws + WS_A); g.hstepB = (size_t)8 * g.ldb2;
        pg8::gemm_phase(F.lds, g); } SEAM(3);
    moe_block<0>(F, args, bar);
    SEAM(7);
    if (IN(8)) { GemmS1 g; g.nostore = args.flags & 1; g.init_bytes(2048, 2048, F.G, F.bx); g.A = ws + WS_H8; g.Bt = ws + WS_BWIN; g.A2 = (bf16_t*)(ws + WS_A2); g.hstepB = (size_t)8 * g.ldb2;
        pg8::gemm_phase(F.lds, g); } SEAM(8);
    if (IN(9)) { GemmS2 g; g.nostore = args.flags & 1; g.init_plain(256, 384, F.G, F.bx); g.A2 = (const bf16_t*)(ws + WS_A2); g.Et = (const bf16_t*)(ws + WS_SSME); g.Xend = (float*)(ws + WS_XEND);
        pg8::gemm_phase(F.lds, g); }
    if (IN(10)) { scan_phase(F, in); asm volatile("s_waitcnt vmcnt(0)" ::: "memory"); __syncthreads(); }
    if (IN(11)) { GemmS4 g; g.nostore = args.flags & 1; g.init_plain(384, 384, F.G, F.bx); g.A2 = (const bf16_t*)(ws + WS_A2); g.Bs = (const bf16_t*)(ws + WS_SSMB); g.Y = ws + WS_Y; g.hstepB = (size_t)8 * g.ldb2;
        pg8::gemm_phase(F.lds, g); } SEAM(11);
    if (IN(12)) { GemmS5 g; g.nostore = args.flags & 1; g.init_bytes(1024, 0, F.G, F.bx); g.kstepA = 8u * 2048u * 256u; g.Y = ws + WS_Y; g.Bt = ws + WS_BWOUT; g.Z = (bf16_t*)(ws + WS_C); g.R = (const bf16_t*)(ws + WS_A);
        pg8::gemm_phase(F.lds, g); } SEAM(12);
    moe_block<1>(F, args, bar);
#undef IN
#undef SEAM
}

extern "C" void kernel_launch(void* const* d_in, const int* in_sizes, int n_in, void* d_out, int out_size, void* d_ws, size_t ws_size, hipStream_t stream) {
    static int grid = 0;
    if (grid == 0) {
        if (n_in != 26 || in_sizes[0] != NTOK * D || out_size != NTOK * D || ws_size < WS_END) { fprintf(stderr, "kernel_launch: unexpected problem (n_in %d, ws %zu)\n", n_in, ws_size); grid = -1; return; }
        int dev = 0, cus = 0, per_cu = 0;
        if (hipGetDevice(&dev) != hipSuccess || hipDeviceGetAttribute(&cus, hipDeviceAttributeMultiprocessorCount, dev) != hipSuccess) { grid = -1; return; }
        if (hipFuncSetAttribute((const void*)fwd_kernel, hipFuncAttributeMaxDynamicSharedMemorySize, LDS_BYTES) != hipSuccess) { fprintf(stderr, "kernel_launch: hipFuncSetAttribute failed\n"); grid = -1; return; }
        if (hipOccupancyMaxActiveBlocksPerMultiprocessor(&per_cu, (const void*)fwd_kernel, NTHR, LDS_BYTES) != hipSuccess || per_cu < 1) fprintf(stderr, "kernel_launch: occupancy query reports %d\n", per_cu);
        (void)hipGetLastError();
        grid = cus;
        if (grid != 256) fprintf(stderr, "kernel_launch: %d CUs (built for 256)\n", grid);
    }
    if (grid < 0) return;
    if (hipMemsetAsync((char*)d_ws + WS_CTL, 0, CTL_ZERO_BYTES, stream) != hipSuccess) return;
    Args a{};
    for (int i = 0; i < 26; ++i) a.in[i] = (const float*)d_in[i];
    a.out = (float*)d_out; a.ws = (unsigned char*)d_ws;
#if MK_N_LAUNCHES == 1
    a.ph_lo = 0; a.ph_hi = N_PHASES;
    hipLaunchKernelGGL(fwd_kernel, dim3(grid), dim3(NTHR), LDS_BYTES, stream, a);
#else
    for (int p = 0; p < N_PHASES; ++p) { a.ph_lo = p; a.ph_hi = p + 1; for (int r = 0; r < 1 + ((REPEAT_MASK >> p) & 1); ++r) { a.flags = (PROBE_NOSTORE && r == 0 && ((REPEAT_MASK >> p) & 1)) ? 1 : 0; hipLaunchKernelGGL(fwd_kernel, dim3(grid), dim3(NTHR), LDS_BYTES, stream, a); } }
#endif
}
```
